# Optimizing an MI355X kernel written in HIP

```python
import math
import jax
import jax.numpy as jnp
from jax import lax
import numpy as np

D_MODEL = 2048
BATCH = 4
SEQ = 4096
DEPTH = 2

GRID_W = 64
CTX_LEN = 256
EPS = 1e-6
N_MOD = 6
HY_WIDTH = D_MODEL // 4
HY_ORDER = 2
HY_BANDS = 16
HY_EMB = 1 + 2 * HY_BANDS
HY_HIDDEN = 64
HY_FAST_DECAY = 0.3
HY_SLOW_DECAY = 1.5
HY_TARGET = 1e-2
RET_HEADS = 8
RET_V_W = D_MODEL // 2
RET_DV = RET_V_W // RET_HEADS
RET_DK = RET_DV // 2
RET_QK_W = RET_HEADS * RET_DK
RET_CHUNK = 128
S5_WIDTH = D_MODEL // 4
S5_GROUP = 16
S5_GROUPS = S5_WIDTH // S5_GROUP
S5_STATE = 64
D_FF = 256 * ((8 * D_MODEL // 3 + 255) // 256)
IN_WIDTH = 3 * HY_WIDTH + 2 * RET_QK_W + 2 * RET_V_W + S5_WIDTH
MIX_WIDTH = HY_WIDTH + RET_V_W + S5_WIDTH
F32 = jnp.float32

kernel_name = 'hybrid_hyena_retention_s5_dit'


def _rmsnorm(x, g):
    xf = x.astype(F32)
    y = xf * lax.rsqrt(jnp.mean(xf * xf, axis=-1, keepdims=True) + EPS)
    return (y * g.astype(F32)).astype(x.dtype)


def _modulate(x, g, shift, scale):
    return _rmsnorm(x, g) * (1.0 + scale) + shift


def _split_proj(a):
    h3 = 3 * HY_WIDTH
    cuts = [h3, h3 + RET_QK_W, h3 + 2 * RET_QK_W, h3 + 2 * RET_QK_W + RET_V_W,
            h3 + 2 * RET_QK_W + 2 * RET_V_W]
    return jnp.split(a, cuts, axis=-1)


def _short_conv(x, w, b):
    xp = jnp.pad(x, ((0, 0), (1, 1), (0, 0)))
    return xp[:, :-2] * w[0] + xp[:, 1:-1] * w[1] + xp[:, 2:] * w[2] + b


def _hyena_filters(length, w1, b1, w2, b2, w3, freq):
    idx = jnp.arange(length, dtype=F32)
    t = (idx / max(length - 1, 1))[:, None]
    bands = jnp.linspace(1e-4, HY_BANDS - 1, HY_BANDS, dtype=F32)
    ang = (2.0 * math.pi * idx / length)[:, None] * bands[None]
    z = jnp.concatenate([t, jnp.cos(ang), -jnp.sin(ang)], axis=-1)
    freq = freq.astype(F32)
    h = jnp.sin(freq[0] * (z @ w1.astype(F32) + b1.astype(F32)))
    h = jnp.sin(freq[1] * (h @ w2.astype(F32) + b2.astype(F32)))
    h = (h @ w3.astype(F32)).reshape(length, 2, HY_ORDER, HY_WIDTH)
    max_decay = math.log(HY_TARGET) / HY_FAST_DECAY
    min_decay = math.log(HY_TARGET) / HY_SLOW_DECAY
    deltas = jnp.linspace(min_decay, max_decay, HY_WIDTH, dtype=F32)
    h = h * jnp.exp(-t * jnp.abs(deltas))[:, None, None, :]
    k_full = jnp.concatenate([h[:, 0], jnp.zeros_like(h[:1, 0]), jnp.flip(h[1:, 1], axis=0)], axis=0)
    k_full = k_full / jnp.sum(jnp.abs(k_full), axis=0, keepdims=True)
    return jnp.fft.rfft(k_full, axis=0)


def _fft_conv(u, k_f):
    length = u.shape[1]
    u_f = jnp.fft.rfft(u, n=2 * length, axis=1)
    return jnp.fft.irfft(u_f * k_f[None], n=2 * length, axis=1)[:, :length]


def _hyena(p, conv_w, conv_b, w1, b1, w2, b2, w3, freq, bias):
    dtype = p.dtype
    length = p.shape[1]
    p = _short_conv(p, conv_w, conv_b).astype(F32)
    v, x1, x2 = jnp.split(p, 3, axis=-1)
    k_f = _hyena_filters(length, w1, b1, w2, b2, w3, freq)
    bias = bias.astype(F32)
    z = x1 * (_fft_conv(v, k_f[:, 0]) + bias[0] * v)
    y = x2 * (_fft_conv(z, k_f[:, 1]) + bias[1] * z)
    return y.astype(dtype)


def _heads(t, d):
    b, l, _ = t.shape
    return t.astype(F32).reshape(b, l, RET_HEADS, d).transpose(0, 2, 1, 3)


def _retention_dir(q, k, v, log_gamma, init, strict):
    bsz, nh, length, dk = q.shape
    dv = v.shape[-1]
    nc = length // RET_CHUNK
    q = q.reshape(bsz, nh, nc, RET_CHUNK, dk)
    k = k.reshape(bsz, nh, nc, RET_CHUNK, dk)
    v = v.reshape(bsz, nh, nc, RET_CHUNK, dv)
    pos = jnp.arange(RET_CHUNK, dtype=F32)
    diff = pos[:, None] - pos[None, :]
    keep = (diff > 0) if strict else (diff >= 0)
    decay_in = jnp.where(keep, jnp.exp(jnp.maximum(diff, 0.0) * log_gamma[:, None, None]), 0.0)
    scores = jnp.einsum('bhncd,bhnmd->bhncm', q, k) * decay_in[:, None]
    inner = jnp.einsum('bhncm,bhnme->bhnce', scores, v)
    k_dec = k * jnp.exp((RET_CHUNK - 1.0 - pos) * log_gamma[:, None])[:, None, :, None]
    kv = jnp.einsum('bhnmd,bhnme->bhnde', k_dec, v)
    chunk_decay = jnp.exp(RET_CHUNK * log_gamma)[:, None, None]

    def step(state, kv_n):
        return chunk_decay * state + kv_n, state

    final, s_in = lax.scan(step, init, jnp.moveaxis(kv, 2, 0))
    s_in = jnp.moveaxis(s_in, 0, 2)
    q_dec = q * jnp.exp((pos + 1.0) * log_gamma[:, None])[:, None, :, None]
    cross = jnp.einsum('bhncd,bhnde->bhnce', q_dec, s_in)
    return (inner + cross).reshape(bsz, nh, length, dv), final


def _retention_scan(q, k, v, log_gamma, init_f, init_b):
    y_f, s_f = _retention_dir(q, k, v, log_gamma[0], init_f, False)
    fl = lambda t: jnp.flip(t, axis=2)
    y_b, s_b = _retention_dir(fl(q), fl(k), fl(v), log_gamma[1], init_b, True)
    return y_f + fl(y_b), s_f, s_b


def _retention_out(y, g):
    y = y * lax.rsqrt(jnp.mean(y * y, axis=-1, keepdims=True) + EPS)
    b, h, l, dv = y.shape
    y = y.transpose(0, 2, 1, 3).reshape(b, l, h * dv).astype(g.dtype)
    return jax.nn.silu(g) * y


def _s5_params(lam_re, lam_im, log_step, b_re, b_im, c_re, c_im):
    lam = lax.complex(jnp.minimum(lam_re.astype(F32), -1e-4), lam_im.astype(F32))
    step = jnp.exp(log_step.astype(F32))
    b_mat = lax.complex(b_re.astype(F32), b_im.astype(F32))
    c_mat = lax.complex(c_re.astype(F32), c_im.astype(F32))
    return lam, step, b_mat, c_mat


def _s5_combine(e1, e2):
    a1, b1 = e1
    a2, b2 = e2
    return a1 * a2, a2 * b1 + b2


def _s5_dir(u, lam, step, b_mat, c_mat, init):
    lam_dt = lam * step[:, None]
    lam_bar = jnp.exp(lam_dt)
    b_bar = ((lam_bar - 1.0) / lam)[:, :, None] * b_mat
    bu = jnp.einsum('blgi,gpi->blgp', u, b_bar)
    a = jnp.broadcast_to(lam_bar, bu.shape)
    _, xs = lax.associative_scan(_s5_combine, (a, bu), axis=1)
    if init is not None:
        n = jnp.arange(1, u.shape[1] + 1, dtype=F32)
        xs = xs + jnp.exp(n[:, None, None] * lam_dt)[None] * init[:, None]
    y = jnp.einsum('blgp,gip->blgi', xs, c_mat).real
    return y, xs[:, -1]


def _s5_scan(u, lam, step, b_mat, c_mat, init_f, init_b):
    bsz, l, _ = u.shape
    ug = u.astype(F32).reshape(bsz, l, S5_GROUPS, S5_GROUP).astype(jnp.complex64)
    y_f, s_f = _s5_dir(ug, lam[0], step[0], b_mat[0], c_mat[0], init_f)
    y_b, s_b = _s5_dir(jnp.flip(ug, axis=1), lam[1], step[1], b_mat[1], c_mat[1], init_b)
    y = (y_f + jnp.flip(y_b, axis=1)).reshape(bsz, l, S5_WIDTH)
    return y, s_f, s_b


def _s5_out(y, u, d, glu_w, glu_b):
    z = jax.nn.gelu((y + d.astype(F32) * u.astype(F32)).astype(u.dtype))
    return z * jax.nn.sigmoid(z @ glu_w + glu_b)


def _conv_ffn(h, w_up, conv_w, conv_b, w_down, rows, width):
    bsz, l, _ = h.shape
    gate, val = jnp.split(h @ w_up, 2, axis=-1)
    gate = gate.reshape(bsz, rows, width, D_FF)
    gate = lax.conv_general_dilated(gate, conv_w[:, :, None, :], (1, 1), 'SAME',
                                    dimension_numbers=('NHWC', 'HWIO', 'NHWC'),
                                    feature_group_count=D_FF) + conv_b
    gate = gate.reshape(bsz, l, D_FF)
    return (jax.nn.gelu(gate) * val) @ w_down


def setup_inputs(seed: int = 0) -> dict:
    key = jax.random.key(seed)
    ks = iter(jax.random.split(key, 48))
    nrm = lambda shape, std: std * jax.random.normal(next(ks), shape, F32)
    D = D_MODEL
    x = nrm((BATCH, SEQ, D), 1.0)
    c = nrm((BATCH, D), 1.0)
    ctx = nrm((BATCH, CTX_LEN, D), 1.0)
    c_ctx = nrm((D,), 1.0)
    ada_w = nrm((DEPTH, D, N_MOD * D), 0.5 * D ** -0.5)
    ada_b = nrm((DEPTH, N_MOD * D), 0.01)
    norm1_g = 1.0 + nrm((DEPTH, D), 0.02)
    w_in = nrm((DEPTH, D, IN_WIDTH), D ** -0.5)
    hy_conv_w = nrm((DEPTH, 3, 3 * HY_WIDTH), 3 ** -0.5)
    hy_conv_b = nrm((DEPTH, 3 * HY_WIDTH), 0.01)
    hy_w1 = nrm((DEPTH, HY_EMB, HY_HIDDEN), HY_EMB ** -0.5)
    hy_b1 = nrm((DEPTH, HY_HIDDEN), 0.1)
    hy_w2 = nrm((DEPTH, HY_HIDDEN, HY_HIDDEN), HY_HIDDEN ** -0.5)
    hy_b2 = nrm((DEPTH, HY_HIDDEN), 0.1)
    hy_w3 = nrm((DEPTH, HY_HIDDEN, 2 * HY_ORDER * HY_WIDTH), HY_HIDDEN ** -0.5)
    hy_freq = 1.0 + nrm((DEPTH, 2, HY_HIDDEN), 0.02)
    hy_bias = nrm((DEPTH, HY_ORDER, HY_WIDTH), 0.5)
    gamma = 1.0 - 2.0 ** (-5.0 - jnp.arange(RET_HEADS, dtype=F32))
    ret_decay = jnp.log(-jnp.log(gamma))[None, None] + nrm((DEPTH, 2, RET_HEADS), 0.01)
    s5_shape = (DEPTH, 2, S5_GROUPS, S5_STATE)
    s5_lam_re = -0.5 + nrm(s5_shape, 0.01)
    s5_lam_im = jnp.broadcast_to(math.pi * jnp.arange(S5_STATE, dtype=F32), s5_shape) + nrm(s5_shape, 0.01)
    s5_log_step = jax.random.uniform(next(ks), (DEPTH, 2, S5_GROUPS), F32, math.log(1e-3), math.log(1e-1))
    s5_b_re = nrm((DEPTH, 2, S5_GROUPS, S5_STATE, S5_GROUP), (2 * S5_GROUP) ** -0.5)
    s5_b_im = nrm((DEPTH, 2, S5_GROUPS, S5_STATE, S5_GROUP), (2 * S5_GROUP) ** -0.5)
    s5_c_re = nrm((DEPTH, 2, S5_GROUPS, S5_GROUP, S5_STATE), 0.35)
    s5_c_im = nrm((DEPTH, 2, S5_GROUPS, S5_GROUP, S5_STATE), 0.35)
    s5_d = nrm((DEPTH, S5_WIDTH), 1.0)
    s5_glu_w = nrm((DEPTH, S5_WIDTH, S5_WIDTH), S5_WIDTH ** -0.5)
    s5_glu_b = nrm((DEPTH, S5_WIDTH), 0.01)
    w_out = nrm((DEPTH, MIX_WIDTH, D), MIX_WIDTH ** -0.5)
    norm2_g = 1.0 + nrm((DEPTH, D), 0.02)
    ffn_w_up = nrm((DEPTH, D, 2 * D_FF), D ** -0.5)
    ffn_conv_w = nrm((DEPTH, 3, 3, D_FF), 1.0 / 3.0)
    ffn_conv_b = nrm((DEPTH, D_FF), 0.01)
    ffn_w_down = nrm((DEPTH, D_FF, D), D_FF ** -0.5)
    norm_f = 1.0 + nrm((D,), 0.02)
    return {'x': x, 'c': c, 'ctx': ctx, 'c_ctx': c_ctx, 'ada_w': ada_w, 'ada_b': ada_b,
            'norm1_g': norm1_g, 'w_in': w_in, 'hy_conv_w': hy_conv_w, 'hy_conv_b': hy_conv_b,
            'hy_w1': hy_w1, 'hy_b1': hy_b1, 'hy_w2': hy_w2, 'hy_b2': hy_b2, 'hy_w3': hy_w3,
            'hy_freq': hy_freq, 'hy_bias': hy_bias, 'ret_decay': ret_decay,
            's5_lam_re': s5_lam_re, 's5_lam_im': s5_lam_im, 's5_log_step': s5_log_step,
            's5_b_re': s5_b_re, 's5_b_im': s5_b_im, 's5_c_re': s5_c_re, 's5_c_im': s5_c_im,
            's5_d': s5_d, 's5_glu_w': s5_glu_w, 's5_glu_b': s5_glu_b, 'w_out': w_out,
            'norm2_g': norm2_g, 'ffn_w_up': ffn_w_up, 'ffn_conv_w': ffn_conv_w,
            'ffn_conv_b': ffn_conv_b, 'ffn_w_down': ffn_w_down, 'norm_f': norm_f}


def reference(x, c, ctx, c_ctx, ada_w, ada_b, norm1_g, w_in, hy_conv_w, hy_conv_b,
              hy_w1, hy_b1, hy_w2, hy_b2, hy_w3, hy_freq, hy_bias, ret_decay,
              s5_lam_re, s5_lam_im, s5_log_step, s5_b_re, s5_b_im, s5_c_re, s5_c_im,
              s5_d, s5_glu_w, s5_glu_b, w_out, norm2_g, ffn_w_up, ffn_conv_w,
              ffn_conv_b, ffn_w_down, norm_f):
    bsz, length, _ = x.shape
    rows = length // GRID_W
    ctx_len = ctx.shape[1]
    h_lat, h_ctx = x, ctx
    for i in range(DEPTH):
        last = i == DEPTH - 1
        m_lat = jnp.split((jax.nn.silu(c) @ ada_w[i] + ada_b[i])[:, None, :], N_MOD, axis=-1)
        m_ctx = jnp.split(jax.nn.silu(c_ctx) @ ada_w[i] + ada_b[i], N_MOD, axis=-1)
        a_lat = _modulate(h_lat, norm1_g[i], m_lat[0], m_lat[1]) @ w_in[i]
        a_ctx = _modulate(h_ctx, norm1_g[i], m_ctx[0], m_ctx[1]) @ w_in[i]
        hy_l, q_l, k_l, v_l, g_l, u_l = _split_proj(a_lat)
        hy_c, q_c, k_c, v_c, g_c, u_c = _split_proj(a_ctx)
        log_gamma = -jnp.exp(ret_decay[i].astype(F32))
        lam, step, b_mat, c_mat = _s5_params(s5_lam_re[i], s5_lam_im[i], s5_log_step[i],
                                             s5_b_re[i], s5_b_im[i], s5_c_re[i], s5_c_im[i])
        zero = jnp.zeros((bsz, RET_HEADS, RET_DK, RET_DV), F32)
        r_c, rs_f, rs_b = _retention_scan(_heads(q_c, RET_DK), _heads(k_c, RET_DK) * RET_DK ** -0.5,
                                          _heads(v_c, RET_DV), log_gamma, zero, zero)
        y5_c, ss_f, ss_b = _s5_scan(u_c, lam, step, b_mat, c_mat, None, None)
        r_l, _, _ = _retention_scan(_heads(q_l, RET_DK), _heads(k_l, RET_DK) * RET_DK ** -0.5,
                                    _heads(v_l, RET_DV), log_gamma, rs_f, rs_b)
        y5_l, _, _ = _s5_scan(u_l, lam, step, b_mat, c_mat, ss_f, ss_b)
        hyena_l = _hyena(hy_l, hy_conv_w[i], hy_conv_b[i], hy_w1[i], hy_b1[i], hy_w2[i], hy_b2[i],
                         hy_w3[i], hy_freq[i], hy_bias[i])
        mix_l = jnp.concatenate([hyena_l, _retention_out(r_l, g_l),
                                 _s5_out(y5_l, u_l, s5_d[i], s5_glu_w[i], s5_glu_b[i])], axis=-1) @ w_out[i]
        if not last:
            hyena_c = _hyena(hy_c, hy_conv_w[i], hy_conv_b[i], hy_w1[i], hy_b1[i], hy_w2[i], hy_b2[i],
                             hy_w3[i], hy_freq[i], hy_bias[i])
            mix_c = jnp.concatenate([hyena_c, _retention_out(r_c, g_c),
                                     _s5_out(y5_c, u_c, s5_d[i], s5_glu_w[i], s5_glu_b[i])], axis=-1) @ w_out[i]
            h_ctx = h_ctx + m_ctx[2] * mix_c
            h_ctx = h_ctx + m_ctx[5] * _conv_ffn(_modulate(h_ctx, norm2_g[i], m_ctx[3], m_ctx[4]),
                                                 ffn_w_up[i], ffn_conv_w[i], ffn_conv_b[i], ffn_w_down[i],
                                                 1, ctx_len)
        h_lat = h_lat + m_lat[2] * mix_l
        h_lat = h_lat + m_lat[5] * _conv_ffn(_modulate(h_lat, norm2_g[i], m_lat[3], m_lat[4]),
                                             ffn_w_up[i], ffn_conv_w[i], ffn_conv_b[i], ffn_w_down[i],
                                             rows, GRID_W)
    return _rmsnorm(h_lat, norm_f)
```

```cpp
#include <hip/hip_runtime.h>
#include <hip/hip_cooperative_groups.h>
#include <cstdio>
namespace cg = cooperative_groups;

#define LAS __attribute__((address_space(3)))
typedef unsigned short bf16_t;
typedef short bf16x8 __attribute__((ext_vector_type(8)));
typedef float f32x4 __attribute__((ext_vector_type(4)));
typedef unsigned u32x4 __attribute__((ext_vector_type(4)));
typedef unsigned u32x2 __attribute__((ext_vector_type(2)));
typedef float c2 __attribute__((ext_vector_type(2)));

#ifndef REP_MASK
#define REP_MASK 0
#endif
#define NREP(bit) ((REP_MASK >> (bit)) & 1 ? 2 : 1)
#if (REP_MASK >> 2) & 1
#define GEMM_REP(stmt) stmt stmt
#else
#define GEMM_REP(stmt) stmt
#endif
#ifndef EN_RET
#define EN_RET 1
#endif
#ifndef EN_S5
#define EN_S5 1
#endif
#ifndef EN_HY
#define EN_HY 1
#endif

struct Params {
    const float* in[35];
    float* out;
    unsigned char* ws;
    unsigned long long ws_size;
};

typedef const __attribute__((address_space(4))) Params& PRef;
__device__ __forceinline__ PRef getp() { const __attribute__((address_space(4))) Params* kp = (const __attribute__((address_space(4))) Params*)__builtin_amdgcn_kernarg_segment_ptr(); asm volatile("" : "+s"(kp)); return *kp; }
constexpr int D = 2048, NB = 4, SEQ = 4096, LC = 256, RL = NB * SEQ, RC = NB * LC, RT = RL + RC;
constexpr int NIN = 5120, NFF = 5632, NUP = 11264;
constexpr int C_Q = 1536, C_K = 2048, C_V = 2560, C_G = 3584, C_U = 4608;
constexpr int LDS_BYTES = 143360, SCR_OFF = 139264, SCR_WCOL = 64, SCR_TW = 1088, FFT_PAD = 8704;

constexpr size_t al256(size_t x) { return (x + 255) & ~(size_t)255; }
constexpr size_t O_WT_IN = 0;
constexpr size_t O_WT_OUT = O_WT_IN + (size_t)5120 * 2048 * 2;
constexpr size_t O_WT_UP = O_WT_OUT + (size_t)2048 * 2048 * 2;
constexpr size_t O_WT_DOWN = O_WT_UP + (size_t)11264 * 2048 * 2;
constexpr size_t O_WT_GLU = O_WT_DOWN + (size_t)2048 * 5632 * 2;
constexpr size_t O_HCTX = O_WT_GLU + (size_t)512 * 512 * 2;
constexpr size_t O_MOD = O_HCTX + (size_t)RC * 2048 * 4;
constexpr size_t O_HID = O_MOD + al256((size_t)2 * 5 * 12288 * 4);
constexpr size_t O_TW = O_HID + (size_t)2 * 4352 * 64 * 4;
constexpr size_t O_KF = O_TW + 4096 * 8;
constexpr size_t O_KFC = O_KF + (size_t)2 * 512 * 8192 * 8;
constexpr size_t O_S5E = O_KFC + (size_t)2 * 512 * 512 * 8;
constexpr size_t O_S5G = O_S5E + (size_t)64 * 128 * 1024 * 2;
constexpr size_t O_S5K = O_S5G + (size_t)64 * 1024 * 128 * 2;
constexpr size_t O_S5LT = O_S5K + al256((size_t)32 * 127 * 256 * 2);
constexpr size_t O_XN = O_S5LT + 64 * 64 * 8;
constexpr size_t O_U = O_XN + (size_t)RT * 2048 * 2;
constexpr size_t O_A = O_U;
constexpr size_t O_HYT = O_A + (size_t)RT * 5120 * 2;
constexpr size_t O_HYTC = O_HYT + (size_t)4 * 1536 * 4096 * 2;
constexpr size_t O_HYY = O_HYTC + (size_t)4 * 1536 * 256 * 2;
constexpr size_t O_HYYC = O_HYY + (size_t)4 * 512 * 4096 * 4;
constexpr size_t O_Z5 = O_HYYC + (size_t)4 * 512 * 256 * 4;
constexpr size_t O_RETST = O_Z5 + (size_t)RT * 512 * 2;
constexpr size_t O_S5ST = O_RETST + (size_t)64 * 34 * 8192 * 4;
constexpr size_t O_MIXEND = O_S5ST + (size_t)256 * 68 * 128 * 4;
constexpr size_t O_GV = O_U;
constexpr size_t O_END = O_GV + (size_t)RT * 11264 * 2;
static_assert(O_MIXEND <= O_END, "mixer buffers must fit in the union region");
constexpr size_t O_QCTR = O_END;
constexpr size_t O_BAR = O_QCTR + 256;
constexpr size_t O_END2 = O_BAR + 8192;

__device__ __forceinline__ int otid() { int t = (int)__builtin_amdgcn_workitem_id_x(); asm volatile("" : "+v"(t)); return t; }
__device__ __forceinline__ unsigned cvt_pk_bf16(float lo, float hi) { unsigned r; asm("v_cvt_pk_bf16_f32 %0, %1, %2" : "=v"(r) : "v"(lo), "v"(hi)); return r; }
__device__ __forceinline__ float bf2f(unsigned short b) { return __uint_as_float(((unsigned)b) << 16); }
__device__ __forceinline__ float bflo(unsigned w) { return __uint_as_float(w << 16); }
__device__ __forceinline__ float bfhi(unsigned w) { return __uint_as_float(w & 0xffff0000u); }
__device__ __forceinline__ unsigned short f2bf(float f) { return (unsigned short)(cvt_pk_bf16(f, 0.f) & 0xffffu); }
__device__ __forceinline__ float sigmoidf_(float x) { return 1.f / (1.f + __expf(-x)); }
__device__ __forceinline__ float gelu_tanh(float x) { const float u = 0.7978845608028654f * (x + 0.044715f * x * x * x); return x / (1.f + __expf(-2.f * u)); }
__device__ __forceinline__ float wave_sum(float v) {
#pragma unroll
    for (int o = 1; o < 64; o <<= 1) v += __shfl_xor(v, o);
    return v;
}
__device__ __forceinline__ c2 mkc2(float x, float y) { c2 r; r.x = x; r.y = y; return r; }
__device__ __forceinline__ c2 cmul(c2 a, c2 b) { return mkc2(a.x * b.x - a.y * b.y, a.x * b.y + a.y * b.x); }
__device__ __forceinline__ c2 cmulc(c2 a, c2 b) { return mkc2(a.x * b.x + a.y * b.y, a.y * b.x - a.x * b.y); }
__device__ __forceinline__ bf16x8 mk8(u32x4 w) { union { u32x4 u; bf16x8 b; } x; x.u = w; return x.b; }
__device__ __forceinline__ u32x4 un8(bf16x8 b) { union { u32x4 u; bf16x8 b; } x; x.b = b; return x.u; }

namespace pg8 {
constexpr int BM = 256, BK = 64, HALF = 128, HTB = HALF * BK * 2, STAGE_BYTES = 8 * HTB, NXCD = 8, WGM = 8;
__host__ __device__ __forceinline__ int lds_byte(int r, int c) { const int st = (r >> 4) * 2 + (c >> 5), rr = r & 15, cc = c & 31, ob = rr * 64 + cc * 2; return st * 1024 + (ob ^ (((ob >> 9) & 1) << 5)); }
__host__ __device__ __forceinline__ void stage_rc(int b, int& R, int& C) { const int st = b / 1024, sb = b % 1024, swz = sb ^ (((sb >> 9) & 1) << 5); R = (st >> 1) * 16 + swz / 64; C = (st & 1) * 32 + (swz % 64) / 2; }
__host__ __device__ __forceinline__ int perm32(int rho) { const int n = rho >> 4, i = rho & 15; return 8 * (i >> 2) + 4 * n + (i & 3); }
struct Unit { int pm, pn; };
struct Gemm { const bf16_t* A; const bf16_t* Bt; int M, N, K, lda, ldb; };
struct StaticOrder {
    int nM, nN, nwg, G, c;
    __device__ void init(int M, int N, int G_, int c_) { nM = M / BM; nN = N / BM; nwg = nM * nN; G = G_; c = c_; }
    __device__ bool next(int i, Unit& u) const {
        const long L = (long)i * G + c; if (L >= nwg) return false;
        int wgid = (int)L; { const int q = nwg / NXCD, r = nwg % NXCD, xcd = wgid % NXCD, off = wgid / NXCD; wgid = (xcd < r ? xcd * (q + 1) : r * (q + 1) + (xcd - r) * q) + off; }
        const int nig = WGM * nN, gid = wgid / nig, fm = gid * WGM, gsz = (nM - fm) < WGM ? (nM - fm) : WGM;
        u.pm = fm + ((wgid % nig) % gsz); u.pn = (wgid % nig) / gsz; return true;
    }
};

struct SingleOrder { int pm, pn; bool has; __device__ __forceinline__ bool next(int i, Unit& u) const { u.pm = pm; u.pn = pn; return has && i == 0; } };
template <class Epi, class Sched>
__device__ __forceinline__ void gemm_phase(LAS unsigned char* lds, const Gemm g, const Sched& S, const Epi& E) {
    const int tid = otid(), wid = __builtin_amdgcn_readfirstlane(tid >> 6), lane = tid & 63, wr = wid >> 2, wc = wid & 3, fr = lane & 15, fq = lane >> 4;
    const int K = g.K, nt = K / BK, lda = g.lda, ldb = g.ldb;
    unsigned voffA, voffB;
    { int R, C; stage_rc(tid * 16, R, C); const int Rb = Epi::PERM ? ((R & ~31) + perm32(R & 31)) : R;
      voffA = (unsigned)(R * lda + C) * 2u; voffB = (unsigned)(Rb * ldb + C) * 2u; }
    const size_t r64voffA = (size_t)64 * lda * 2, r64voffB = (size_t)64 * ldb * 2;
    const size_t kstep = (size_t)(BK * 2);
    const size_t hstepA = (size_t)HALF * lda * 2, hstepB = (size_t)HALF * ldb * 2;
    const size_t tstepA = 2 * hstepA, tstepB = 2 * hstepB;
    const unsigned ldsw = (unsigned)wid * 1024u;
    const int aoff = lds_byte(wr * 64 + fr, fq * 8), boff = lds_byte(wc * 32 + fr, fq * 8);
#define PG8_SA(b, h) (((b) * 2 + (h)) * HTB)
#define PG8_SB(b, h) ((4 + (b) * 2 + (h)) * HTB)
#define PG8_STAGE(bufoff, gbase, voff) do { _Pragma("unroll") for (int _i = 0; _i < 2; ++_i) \
        __builtin_amdgcn_global_load_lds((const unsigned*)((const char*)(gbase) + (size_t)_i * r64##voff + (voff)), (LAS unsigned*)(lds + (bufoff) + ldsw + _i * 8192), 16, 0, 0); } while (0)
#define PG8_LDA(dst, b, h) do { _Pragma("unroll") for (int m = 0; m < 4; ++m) _Pragma("unroll") for (int k = 0; k < 2; ++k) dst[m][k] = *(const LAS bf16x8*)(lds + PG8_SA(b, h) + aoff + m * 2048 + k * 1024); } while (0)
#define PG8_LDB(dst, b, h) do { _Pragma("unroll") for (int n = 0; n < 2; ++n) _Pragma("unroll") for (int k = 0; k < 2; ++k) dst[n][k] = *(const LAS bf16x8*)(lds + PG8_SB(b, h) + boff + n * 2048 + k * 1024); } while (0)
#define PG8_MMA(ai, bj, At, Bt) do { __builtin_amdgcn_s_setprio(1); _Pragma("unroll") for (int m = 0; m < 4; ++m) _Pragma("unroll") for (int n = 0; n < 2; ++n) _Pragma("unroll") for (int k = 0; k < 2; ++k) \
        acc[ai][bj][m][n] = __builtin_amdgcn_mfma_f32_16x16x32_bf16(Bt[n][k], At[m][k], acc[ai][bj][m][n], 0, 0, 0); __builtin_amdgcn_s_setprio(0); } while (0)
#define PG8_WAIT_V(n) asm volatile("s_waitcnt vmcnt(" #n ")" ::: "memory")
#define PG8_WAIT_L(n) asm volatile("s_waitcnt lgkmcnt(" #n ")" ::: "memory")
#define PG8_BAR __builtin_amdgcn_s_barrier()
#define PG8_SCHED __builtin_amdgcn_sched_barrier(0)
    Unit cur, nxt; int ui = 0;
    if (!S.next(0, cur)) return;
    f32x4 acc[2][2][4][2];
#pragma unroll
    for (int a = 0; a < 2; ++a)
#pragma unroll
        for (int b = 0; b < 2; ++b)
#pragma unroll
            for (int m = 0; m < 4; ++m)
#pragma unroll
                for (int n = 0; n < 2; ++n) acc[a][b][m][n] = (f32x4){0.f, 0.f, 0.f, 0.f};
    bf16x8 At[4][2], B0[2][2], B1[2][2];
    const char* cA = (const char*)g.A + (size_t)cur.pm * tstepA; const char* cB = (const char*)g.Bt + (size_t)cur.pn * tstepB;
    PG8_STAGE(PG8_SB(0, 0), cB, voffB); PG8_STAGE(PG8_SA(0, 0), cA, voffA); PG8_STAGE(PG8_SB(0, 1), cB + hstepB, voffB); PG8_STAGE(PG8_SA(0, 1), cA + hstepA, voffA);
    if (wr == 1) PG8_BAR;
    PG8_WAIT_V(4); PG8_BAR;
    PG8_STAGE(PG8_SB(1, 0), cB + kstep, voffB); PG8_STAGE(PG8_SA(1, 0), cA + kstep, voffA); PG8_STAGE(PG8_SB(1, 1), cB + hstepB + kstep, voffB);
    PG8_WAIT_V(6); PG8_BAR;
    for (;;) {
        const bool has_next = S.next(ui + 1, nxt);
        const char* nA = has_next ? (const char*)g.A + (size_t)nxt.pm * tstepA : cA; const char* nB = has_next ? (const char*)g.Bt + (size_t)nxt.pn * tstepB : cB;
        for (int t = 0; t < nt; t += 2) {
            const bool last = (t == nt - 2);
            const char* a1 = cA + (size_t)(t + 1) * kstep;
            const char* a2 = last ? nA : cA + (size_t)(t + 2) * kstep; const char* b2 = last ? nB : cB + (size_t)(t + 2) * kstep;
            const char* a3 = a2 + kstep; const char* b3 = b2 + kstep;
            PG8_LDB(B0, 0, 0); PG8_SCHED; PG8_LDA(At, 0, 0); PG8_STAGE(PG8_SA(1, 1), a1 + hstepA, voffA);
            PG8_WAIT_L(8); PG8_BAR; PG8_WAIT_L(0); PG8_MMA(0, 0, At, B0); PG8_BAR; PG8_SCHED;
            PG8_LDB(B1, 0, 1); PG8_STAGE(PG8_SB(0, 0), b2, voffB);
            PG8_BAR; PG8_WAIT_L(0); PG8_MMA(0, 1, At, B1); PG8_BAR;
            PG8_LDA(At, 0, 1); PG8_STAGE(PG8_SA(0, 0), a2, voffA);
            PG8_BAR; PG8_WAIT_L(0); PG8_MMA(1, 0, At, B0); PG8_BAR; PG8_SCHED;
            PG8_STAGE(PG8_SB(0, 1), b2 + hstepB, voffB);
            PG8_WAIT_V(6); PG8_BAR; PG8_MMA(1, 1, At, B1); PG8_BAR;
            PG8_LDB(B0, 1, 0); PG8_SCHED; PG8_LDA(At, 1, 0); PG8_STAGE(PG8_SA(0, 1), a2 + hstepA, voffA);
            PG8_WAIT_L(8); PG8_BAR; PG8_WAIT_L(0); PG8_MMA(0, 0, At, B0); PG8_BAR; PG8_SCHED;
            PG8_LDB(B1, 1, 1); PG8_STAGE(PG8_SB(1, 0), b3, voffB);
            PG8_BAR; PG8_WAIT_L(0); PG8_MMA(0, 1, At, B1); PG8_BAR;
            PG8_LDA(At, 1, 1); PG8_STAGE(PG8_SA(1, 0), a3, voffA);
            PG8_BAR; PG8_WAIT_L(0); PG8_MMA(1, 0, At, B0); PG8_BAR; PG8_SCHED;
            PG8_STAGE(PG8_SB(1, 1), b3 + hstepB, voffB);
            PG8_WAIT_V(6); PG8_BAR; PG8_MMA(1, 1, At, B1); PG8_BAR;
        }
        E(acc, cur, wr, wc, fr, fq);
        if (!has_next) break;
#pragma unroll
        for (int a = 0; a < 2; ++a)
#pragma unroll
            for (int b = 0; b < 2; ++b)
#pragma unroll
                for (int m = 0; m < 4; ++m)
#pragma unroll
                    for (int n = 0; n < 2; ++n) acc[a][b][m][n] = (f32x4){0.f, 0.f, 0.f, 0.f};
        cur = nxt; cA = nA; cB = nB; ++ui;
    }
    PG8_WAIT_V(0);
    if (wr == 0) PG8_BAR;
    PG8_BAR;
#undef PG8_SA
#undef PG8_SB
#undef PG8_STAGE
#undef PG8_LDA
#undef PG8_LDB
#undef PG8_MMA
#undef PG8_WAIT_V
#undef PG8_WAIT_L
#undef PG8_BAR
#undef PG8_SCHED
}
}

struct EpiStoreBf16 {
    static constexpr bool PERM = true;
    bf16_t* O; int ldc;
    __device__ __forceinline__ void operator()(const f32x4 (&acc)[2][2][4][2], const pg8::Unit& u, int wr_, int wc_, int fr_, int fq_) const {
        const int t2_ = otid(), wr = t2_ >> 8, wc = (t2_ >> 6) & 3, fr = t2_ & 15, fq = (t2_ >> 4) & 3; (void)wr_; (void)wc_; (void)fr_; (void)fq_;
        const int row0 = u.pm * 256 + wr * 64 + fr, col0 = u.pn * 256 + wc * 32 + 8 * fq;
#pragma unroll
        for (int ai = 0; ai < 2; ++ai)
#pragma unroll
            for (int m = 0; m < 4; ++m) { bf16_t* rowp = O + (size_t)(row0 + ai * 128 + m * 16) * ldc + col0;
#pragma unroll
                for (int bj = 0; bj < 2; ++bj) { const f32x4 v0 = acc[ai][bj][m][0], v1 = acc[ai][bj][m][1];
                    u32x4 w; w.x = cvt_pk_bf16(v0[0], v0[1]); w.y = cvt_pk_bf16(v0[2], v0[3]); w.z = cvt_pk_bf16(v1[0], v1[1]); w.w = cvt_pk_bf16(v1[2], v1[3]);
                    *(u32x4*)(rowp + bj * 128) = w; } }
    }
};
struct EpiGlu {
    static constexpr bool PERM = true;
    const bf16_t* Z; bf16_t* MIX; const float* bias;
    __device__ __forceinline__ void operator()(const f32x4 (&acc)[2][2][4][2], const pg8::Unit& u, int wr_, int wc_, int fr_, int fq_) const {
        const int t2_ = otid(), wr = t2_ >> 8, wc = (t2_ >> 6) & 3, fr = t2_ & 15, fq = (t2_ >> 4) & 3; (void)wr_; (void)wc_; (void)fr_; (void)fq_;
        const int row0 = u.pm * 256 + wr * 64 + fr, col0 = u.pn * 256 + wc * 32 + 8 * fq;
#pragma unroll
        for (int ai = 0; ai < 2; ++ai)
#pragma unroll
            for (int m = 0; m < 4; ++m) { const int row = row0 + ai * 128 + m * 16;
#pragma unroll
                for (int bj = 0; bj < 2; ++bj) { const int col = col0 + bj * 128;
                    const f32x4 b0 = *(const f32x4*)(bias + col), b1 = *(const f32x4*)(bias + col + 4);
                    const f32x4 v0 = acc[ai][bj][m][0] + b0, v1 = acc[ai][bj][m][1] + b1;
                    const u32x4 z = *(const u32x4*)(Z + (size_t)row * 512 + col);
                    u32x4 w;
                    w.x = cvt_pk_bf16(bflo(z.x) * sigmoidf_(v0[0]), bfhi(z.x) * sigmoidf_(v0[1]));
                    w.y = cvt_pk_bf16(bflo(z.y) * sigmoidf_(v0[2]), bfhi(z.y) * sigmoidf_(v0[3]));
                    w.z = cvt_pk_bf16(bflo(z.z) * sigmoidf_(v1[0]), bfhi(z.z) * sigmoidf_(v1[1]));
                    w.w = cvt_pk_bf16(bflo(z.w) * sigmoidf_(v1[2]), bfhi(z.w) * sigmoidf_(v1[3]));
                    *(u32x4*)(MIX + (size_t)row * 2048 + 1536 + col) = w; } }
    }
};
struct EpiResid {
    static constexpr bool PERM = false;
    const float* srcL; const float* srcC; float* dstL; float* dstC; const float* modsel;
    __device__ __forceinline__ void operator()(const f32x4 (&acc)[2][2][4][2], const pg8::Unit& u, int wr_, int wc_, int fr_, int fq_) const {
        const int t2_ = otid(), wr = t2_ >> 8, wc = (t2_ >> 6) & 3, fr = t2_ & 15, fq = (t2_ >> 4) & 3; (void)wr_; (void)wc_; (void)fr_; (void)fq_;
        const int rbase = u.pm * 256;
        const bool isc = rbase >= RL;
        const int mr = isc ? 4 : (rbase >> 12);
        const float* gate = modsel + (size_t)mr * 12288;
        const float* src = isc ? srcC - (size_t)RL * 2048 : srcL;
        float* dst = isc ? dstC - (size_t)RL * 2048 : dstL;
        const int row0 = rbase + wr * 64 + fr, col0 = u.pn * 256 + wc * 32 + 4 * fq;
#pragma unroll
        for (int ai = 0; ai < 2; ++ai)
#pragma unroll
            for (int m = 0; m < 4; ++m) { const size_t ro = (size_t)(row0 + ai * 128 + m * 16) * 2048;
#pragma unroll
                for (int bj = 0; bj < 2; ++bj)
#pragma unroll
                    for (int n = 0; n < 2; ++n) { const int col = col0 + bj * 128 + n * 16;
                        const f32x4 gg = *(const f32x4*)(gate + col), s = *(const f32x4*)(src + ro + col);
                        *(f32x4*)(dst + ro + col) = s + gg * acc[ai][bj][m][n]; } }
    }
};

struct EpiResidAtomic {
    static constexpr bool PERM = false;
    float* dstC; const float* gate;
    __device__ __forceinline__ void operator()(const f32x4 (&acc)[2][2][4][2], const pg8::Unit& u, int wr_, int wc_, int fr_, int fq_) const {
        const int t2_ = otid(), wr = t2_ >> 8, wc = (t2_ >> 6) & 3, fr = t2_ & 15, fq = (t2_ >> 4) & 3; (void)wr_; (void)wc_; (void)fr_; (void)fq_;
        float* dst = dstC - (size_t)RL * 2048;
        const int row0 = u.pm * 256 + wr * 64 + fr, col0 = u.pn * 256 + wc * 32 + 4 * fq;
#pragma unroll
        for (int ai = 0; ai < 2; ++ai)
#pragma unroll
            for (int m = 0; m < 4; ++m) { const size_t ro = (size_t)(row0 + ai * 128 + m * 16) * 2048;
#pragma unroll
                for (int bj = 0; bj < 2; ++bj)
#pragma unroll
                    for (int n = 0; n < 2; ++n) { const int col = col0 + bj * 128 + n * 16;
                        const f32x4 v = *(const f32x4*)(gate + col) * acc[ai][bj][m][n];
                        __hip_atomic_fetch_add(dst + ro + col, v[0], __ATOMIC_RELAXED, __HIP_MEMORY_SCOPE_AGENT); __hip_atomic_fetch_add(dst + ro + col + 1, v[1], __ATOMIC_RELAXED, __HIP_MEMORY_SCOPE_AGENT);
                        __hip_atomic_fetch_add(dst + ro + col + 2, v[2], __ATOMIC_RELAXED, __HIP_MEMORY_SCOPE_AGENT); __hip_atomic_fetch_add(dst + ro + col + 3, v[3], __ATOMIC_RELAXED, __HIP_MEMORY_SCOPE_AGENT); } }
    }
};

#define PHYS(i) ((i) + ((i) >> 4))
template <int R, bool INV>
__device__ __forceinline__ void fft_pass(LAS c2* buf, int logN, int s_lo, const LAS c2* twab, int ht) {
    const int N = 1 << logN, ngroups = N >> R, tshift = 13 - logN;
    constexpr int NE = 1 << R;
    constexpr float RH = 0.70710678118654752f;
#pragma unroll 2
    for (int q = ht; q < ngroups; q += 256) {
        const int qlo = q & (s_lo - 1), base = ((q - qlo) << R) + qlo;
        c2 x[NE];
#pragma unroll
        for (int k = 0; k < NE; ++k) x[k] = buf[PHYS(base + k * s_lo)];
#pragma unroll
        for (int u = 0; u < R; ++u) {
            const int h = INV ? (1 << u) : (1 << (R - 1 - u));
            const int e = (qlo * (N / (2 * h * s_lo))) << tshift;
            const c2 T = cmul(twab[e >> 6], twab[64 + (e & 63)]);
#pragma unroll
            for (int k = 0; k < NE; ++k) {
                if (k & h) continue;
                const int j8 = (k & (h - 1)) * (4 / h);
                const float cr = (j8 == 0) ? 1.f : (j8 == 1) ? RH : (j8 == 2) ? 0.f : -RH;
                const float ci = (j8 == 0) ? 0.f : (j8 == 1) ? -RH : (j8 == 2) ? -1.f : -RH;
                const c2 w = cmul(T, mkc2(cr, ci));
                if (!INV) { const c2 a = x[k], b = x[k + h]; x[k] = mkc2(a.x + b.x, a.y + b.y); x[k + h] = cmul(mkc2(a.x - b.x, a.y - b.y), w); }
                else { const c2 a = x[k], b = cmulc(x[k + h], w); x[k] = mkc2(a.x + b.x, a.y + b.y); x[k + h] = mkc2(a.x - b.x, a.y - b.y); }
            }
        }
#pragma unroll
        for (int k = 0; k < NE; ++k) buf[PHYS(base + k * s_lo)] = x[k];
    }
}
__device__ __forceinline__ void fft_fwd(LAS c2* buf, int logN, const LAS c2* tw, int ht) {
    __syncthreads();
    if (logN == 13) {
        fft_pass<3, false>(buf, 13, 1024, tw, ht); __syncthreads();
        fft_pass<3, false>(buf, 13, 128, tw, ht); __syncthreads();
        fft_pass<3, false>(buf, 13, 16, tw, ht); __syncthreads();
        fft_pass<3, false>(buf, 13, 2, tw, ht); __syncthreads();
        fft_pass<1, false>(buf, 13, 1, tw, ht); __syncthreads();
    } else {
        fft_pass<3, false>(buf, 9, 64, tw, ht); __syncthreads();
        fft_pass<3, false>(buf, 9, 8, tw, ht); __syncthreads();
        fft_pass<3, false>(buf, 9, 1, tw, ht); __syncthreads();
    }
}
__device__ __forceinline__ void fft_inv(LAS c2* buf, int logN, const LAS c2* tw, int ht) {
    __syncthreads();
    if (logN == 13) {
        fft_pass<1, true>(buf, 13, 1, tw, ht); __syncthreads();
        fft_pass<3, true>(buf, 13, 2, tw, ht); __syncthreads();
        fft_pass<3, true>(buf, 13, 16, tw, ht); __syncthreads();
        fft_pass<3, true>(buf, 13, 128, tw, ht); __syncthreads();
        fft_pass<3, true>(buf, 13, 1024, tw, ht); __syncthreads();
    } else {
        fft_pass<3, true>(buf, 9, 1, tw, ht); __syncthreads();
        fft_pass<3, true>(buf, 9, 8, tw, ht); __syncthreads();
        fft_pass<3, true>(buf, 9, 64, tw, ht); __syncthreads();
    }
}

__device__ __forceinline__ void phase_p0(PRef p, unsigned char* shm) {
    const int tid = otid(), lane = tid & 63, wave = tid >> 6;
    float* mod = (float*)(p.ws + O_MOD); float* hid = (float*)(p.ws + O_HID);
    if (blockIdx.x == 0) for (int i = tid; i < 64 + 2048; i += 512) ((unsigned*)(p.ws + O_QCTR))[i] = 0u;
    { const float4* src = (const float4*)p.in[2]; float4* dst = (float4*)(p.ws + O_HCTX);
      for (int i = blockIdx.x * 512 + tid; i < RC * 2048 / 4; i += gridDim.x * 512) dst[i] = src[i]; }
    constexpr int N_MODIT = 768, N_HIDIT = 1088;
    float* sl = (float*)shm;
    float* part = sl + 5 * 2048;
    for (int it = blockIdx.x; it < N_MODIT + N_HIDIT; it += gridDim.x) {
        if (it < N_MODIT) {
            const int layer = it / 384, col0 = (it % 384) * 32;
#pragma unroll 10
            for (int i = tid; i < 5 * 2048; i += 512) { const int r = i >> 11, k = i & 2047; const float v = r < 4 ? p.in[1][r * 2048 + k] : p.in[3][k]; sl[i] = v * sigmoidf_(v); }
            __syncthreads();
            const int cl = tid & 31, kg = tid >> 5;
            const float* W = p.in[4] + ((size_t)layer * 2048 + kg * 128) * 12288 + col0 + cl;
            float a0 = 0.f, a1 = 0.f, a2 = 0.f, a3 = 0.f, a4 = 0.f;
#pragma unroll 16
            for (int k = 0; k < 128; ++k) { const float w = W[(size_t)k * 12288]; const int kk = kg * 128 + k;
                a0 += sl[kk] * w; a1 += sl[2048 + kk] * w; a2 += sl[4096 + kk] * w; a3 += sl[6144 + kk] * w; a4 += sl[8192 + kk] * w; }
            part[(kg * 5 + 0) * 32 + cl] = a0; part[(kg * 5 + 1) * 32 + cl] = a1; part[(kg * 5 + 2) * 32 + cl] = a2; part[(kg * 5 + 3) * 32 + cl] = a3; part[(kg * 5 + 4) * 32 + cl] = a4;
            __syncthreads();
            if (tid < 160) { const int r = tid >> 5, cc = tid & 31; float s = p.in[5][layer * 12288 + col0 + cc];
                for (int g = 0; g < 16; ++g) s += part[(g * 5 + r) * 32 + cc];
                mod[(size_t)(layer * 5 + r) * 12288 + col0 + cc] = s; }
            __syncthreads();
        } else {
            const int pi = (it - N_MODIT) * 8 + wave;
            const int layer = pi / 4352, q = pi % 4352;
            const int len = q < 4096 ? 4096 : 256, l = q < 4096 ? q : q - 4096;
            const float t = (float)l / (float)(len - 1);
            const float angb = (6.283185307179586f * (float)l) / (float)len;
            const float* w1 = p.in[10] + layer * 33 * 64; const float* w2 = p.in[12] + layer * 64 * 64;
            float pre = p.in[11][layer * 64 + lane] + t * w1[lane];
#pragma unroll 4
            for (int e = 0; e < 16; ++e) { const float band = 1e-4f + (float)e * ((15.f - 1e-4f) / 15.f); float s, c; sincosf(angb * band, &s, &c);
                pre += c * w1[(1 + e) * 64 + lane] - s * w1[(17 + e) * 64 + lane]; }
            const float h1 = sinf(p.in[15][(layer * 2 + 0) * 64 + lane] * pre);
            float* hb = (float*)shm + wave * 64;
            __syncthreads();
            hb[lane] = h1;
            __syncthreads();
            float pre2 = p.in[13][layer * 64 + lane];
#pragma unroll 16
            for (int i = 0; i < 64; ++i) pre2 += hb[i] * w2[i * 64 + lane];
            hid[(size_t)(layer * 4352 + q) * 64 + lane] = sinf(p.in[15][(layer * 2 + 1) * 64 + lane] * pre2);
            __syncthreads();
        }
    }
}

__device__ __forceinline__ void convT_tile(const float* __restrict__ W, int K, int N, bf16_t* __restrict__ WT, int tile, unsigned char* shm, int wave, int lane) {
    const int ntn = N / 64, k0 = (tile / ntn) * 64, n0 = (tile % ntn) * 64;
    float* T = (float*)shm + wave * (64 * 65);
    { const int r4 = lane >> 4, c4 = (lane & 15) * 4;
#pragma unroll
      for (int i = 0; i < 16; ++i) { const int rr = 4 * i + r4; const float4 v = *(const float4*)(W + (size_t)(k0 + rr) * N + n0 + c4);
          T[rr * 65 + c4] = v.x; T[rr * 65 + c4 + 1] = v.y; T[rr * 65 + c4 + 2] = v.z; T[rr * 65 + c4 + 3] = v.w; } }
    __builtin_amdgcn_fence(__ATOMIC_RELEASE, "wavefront"); __builtin_amdgcn_wave_barrier(); __builtin_amdgcn_fence(__ATOMIC_ACQUIRE, "wavefront");
    { const int n8 = lane >> 3, k8 = (lane & 7) * 8;
#pragma unroll
      for (int i = 0; i < 8; ++i) { const int n = 8 * i + n8; const float* sp = T + k8 * 65 + n;
          u32x4 o; o.x = cvt_pk_bf16(sp[0], sp[65]); o.y = cvt_pk_bf16(sp[2 * 65], sp[3 * 65]); o.z = cvt_pk_bf16(sp[4 * 65], sp[5 * 65]); o.w = cvt_pk_bf16(sp[6 * 65], sp[7 * 65]);
          *(u32x4*)(WT + (size_t)(n0 + n) * K + k0 + k8) = o; } }
    __builtin_amdgcn_fence(__ATOMIC_RELEASE, "wavefront"); __builtin_amdgcn_wave_barrier(); __builtin_amdgcn_fence(__ATOMIC_ACQUIRE, "wavefront");
}

__device__ __forceinline__ void s5prep_item(PRef p, int layer, int g, int part, unsigned char* shm) {
    const int tid = otid();
    c2* pw = (c2*)shm;
    c2* bbar = pw + 2 * 64 * 65;
    c2* cm = bbar + 2 * 64 * 16;
    c2* lamdt = cm + 2 * 16 * 64;
    if (tid < 128) { const int dir = tid >> 6, pp = tid & 63; const int o = ((layer * 2 + dir) * 32 + g) * 64 + pp;
        const float st = expf(p.in[20][(layer * 2 + dir) * 32 + g]);
        lamdt[tid] = mkc2(fminf(p.in[18][o], -1e-4f) * st, p.in[19][o] * st); }
    __syncthreads();
    for (int i = tid; i < 2 * 64 * 65; i += 512) { const int dp = i / 65, d = i % 65; const c2 z = lamdt[dp];
        float s, c; sincosf((float)d * z.y, &s, &c); const float m = expf((float)d * z.x); pw[i] = mkc2(m * c, m * s); }
    for (int i = tid; i < 2 * 64 * 16; i += 512) { const int dp = i >> 4, j = i & 15, dir = dp >> 6, pp = dp & 63;
        const int o = ((layer * 2 + dir) * 32 + g) * 64 + pp; const c2 z = lamdt[dp];
        const float st = expf(p.in[20][(layer * 2 + dir) * 32 + g]);
        const c2 lam = mkc2(fminf(p.in[18][o], -1e-4f), p.in[19][o]);
        float s, c; sincosf(z.y, &s, &c); const float sh = sinf(0.5f * z.y);
        const c2 em1 = mkc2(expm1f(z.x) * c - 2.f * sh * sh, expf(z.x) * s);
        const float den = 1.f / (lam.x * lam.x + lam.y * lam.y);
        const c2 coef = mkc2((em1.x * lam.x + em1.y * lam.y) * den, (em1.y * lam.x - em1.x * lam.y) * den);
        (void)st;
        const c2 bm = mkc2(p.in[21][(size_t)o * 16 + j], p.in[22][(size_t)o * 16 + j]);
        bbar[i] = cmul(coef, bm); }
    for (int i = tid; i < 2 * 16 * 64; i += 512) { const int dir = i >> 10, ii = (i >> 6) & 15, pp = i & 63;
        const size_t o = ((size_t)((layer * 2 + dir) * 32 + g) * 16 + ii) * 64 + pp; cm[i] = mkc2(p.in[23][o], p.in[24][o]); }
    __syncthreads();
    bf16_t* E = (bf16_t*)(p.ws + O_S5E); bf16_t* G = (bf16_t*)(p.ws + O_S5G); bf16_t* KT = (bf16_t*)(p.ws + O_S5K); c2* LT = (c2*)(p.ws + O_S5LT);
    if (part == 0 && tid < 128) { const int dir = tid >> 6, pp = tid & 63; LT[(dir * 32 + g) * 64 + pp] = pw[(dir * 64 + pp) * 65 + 64]; }
    for (int i = tid; i < 2 * 32 * 1024; i += 512) { const int dir = i >> 15, rr = (i >> 10) & 31, k = i & 1023; const int row = part * 32 + rr, pp = row >> 1, ri = row & 1, s = k >> 4, j = k & 15;
        const c2 w = cmul(pw[(dir * 64 + pp) * 65 + (dir == 0 ? 63 - s : s)], bbar[(dir * 64 + pp) * 16 + j]);
        E[((size_t)(dir * 32 + g) * 128 + row) * 1024 + k] = f2bf(ri ? w.y : w.x); }
    for (int i = tid; i < 2 * 256 * 128; i += 512) { const int dir = i >> 15, rr = (i >> 7) & 255, k = i & 127; const int t = part * 16 + (rr >> 4), ii = rr & 15, pp = k >> 1, ri = k & 1;
        const c2 w = cmul(cm[(dir * 16 + ii) * 64 + pp], pw[(dir * 64 + pp) * 65 + (dir == 0 ? t + 1 : 64 - t)]);
        G[((size_t)(dir * 32 + g) * 1024 + t * 16 + ii) * 128 + k] = f2bf(ri ? -w.y : w.x); }
    { const int pair = tid & 255, ii = pair >> 4, j = pair & 15, half = tid >> 8;
      const int dir = part < 2 ? 1 : 0;
      float* psum = (float*)(shm + 100352);
#pragma unroll 1
      for (int ph = 0; ph < 2; ++ph) {
          c2 cb[32];
#pragma unroll
          for (int q = 0; q < 32; ++q) { const int pp = ph * 32 + q; cb[q] = cmul(cm[(dir * 16 + ii) * 64 + pp], bbar[(dir * 64 + pp) * 16 + j]);
              if ((q & 7) == 7) asm volatile("" : "+v"(cb[q].x), "+v"(cb[q].y) :: "memory"); }
#pragma unroll 1
          for (int k = 0; k < 16; ++k) { const int dd = part * 32 + half * 16 + k;
              if (dd > 126) continue;
              const int d = dir ? 63 - dd : dd - 63;
              const c2* pwd = pw + (size_t)(dir * 64 + ph * 32) * 65 + d;
              float acc = ph ? psum[k * 512 + tid] : 0.f;
#pragma unroll
              for (int q = 0; q < 32; ++q) { const c2 w = pwd[q * 65]; acc += cb[q].x * w.x - cb[q].y * w.y;
                  if ((q & 7) == 7) asm volatile("" : "+v"(acc) :: "memory"); }
              if (ph == 0) { psum[k * 512 + tid] = acc; continue; }
              if (dd == 63) {
                  for (int pp = 0; pp < 64; ++pp) { const c2 w = cmul(cm[(0 * 16 + ii) * 64 + pp], bbar[(0 * 64 + pp) * 16 + j]); acc += w.x; } }
              KT[((size_t)g * 127 + dd) * 256 + ii * 16 + j] = f2bf(acc); } } }
    __syncthreads();
}

__device__ __forceinline__ void hyfilter_item(PRef p, int layer, bool isctx, int cg4, unsigned char* shm) {
    const int tid = otid(), hb = tid >> 8, ht = tid & 255, lane = tid & 63, wave = tid >> 6, c0 = cg4 * 4;
    const int L = isctx ? 256 : 4096, logN = isctx ? 9 : 13, N = 2 * L;
    const LAS c2* tw = (const LAS c2*)(shm + SCR_OFF + SCR_TW);
    const float* hid = (const float*)(p.ws + O_HID) + (size_t)(layer * 4352 + (isctx ? 4096 : 0)) * 64;
    c2* KF0b = isctx ? (c2*)(p.ws + O_KFC) + (size_t)c0 * 512 : (c2*)(p.ws + O_KF) + (size_t)c0 * 8192;
    c2* KF1b = isctx ? (c2*)(p.ws + O_KFC) + (size_t)(512 + c0) * 512 : (c2*)(p.ws + O_KF) + (size_t)(512 + c0) * 8192;
    float* red = (float*)shm;
    __syncthreads();
    const int fr = lane & 15, fq = lane >> 4;
    const int cdir = fr >> 3, co = (fr >> 2) & 1, ccc = fr & 3;
    bf16x8 bw[2];
    { const float* wp = p.in[14] + (size_t)layer * 64 * 2048 + cdir * 1024 + co * 512 + c0 + ccc;
#pragma unroll
      for (int kk = 0; kk < 2; ++kk) { float wv[8];
#pragma unroll
          for (int i = 0; i < 8; ++i) wv[i] = wp[(size_t)(kk * 32 + fq * 8 + i) * 2048];
          u32x4 w; w.x = cvt_pk_bf16(wv[0], wv[1]); w.y = cvt_pk_bf16(wv[2], wv[3]); w.z = cvt_pk_bf16(wv[4], wv[5]); w.w = cvt_pk_bf16(wv[6], wv[7]); bw[kk] = mk8(w); } }
    const float mind = -4.605170185988091f / 1.5f, maxd = -4.605170185988091f / 0.3f;
    const float adelta = fabsf(mind + (float)(c0 + ccc) * ((maxd - mind) / 511.f));
    float* ST = (float*)(KF0b + (size_t)ccc * N) + co;
    if (tid < 8) ((float*)(KF0b + (size_t)(tid & 3) * N))[2 * L + (tid >> 2)] = 0.f;
    float l1 = 0.f;
#pragma unroll 4
    for (int dt = wave; dt < L / 16; dt += 8) {
        const float* hr = hid + (size_t)(dt * 16 + fr) * 64 + fq * 8;
        f32x4 acc = (f32x4){0.f, 0.f, 0.f, 0.f};
#pragma unroll
        for (int kk = 0; kk < 2; ++kk) { const f32x4 x0 = *(const f32x4*)(hr + kk * 32), x1 = *(const f32x4*)(hr + kk * 32 + 4);
            u32x4 w; w.x = cvt_pk_bf16(x0[0], x0[1]); w.y = cvt_pk_bf16(x0[2], x0[3]); w.z = cvt_pk_bf16(x1[0], x1[1]); w.w = cvt_pk_bf16(x1[2], x1[3]);
            acc = __builtin_amdgcn_mfma_f32_16x16x32_bf16(mk8(w), bw[kk], acc, 0, 0, 0); }
#pragma unroll
        for (int r = 0; r < 4; ++r) { const int d = dt * 16 + fq * 4 + r; const float t = (float)d / (float)(L - 1);
            const float v = acc[r] * expf(-t * adelta);
            if (cdir == 0) { ST[2 * d] = v; l1 += fabsf(v); }
            else if (d >= 1) { ST[2 * (N - d)] = v; l1 += fabsf(v); } } }
    l1 += __shfl_xor(l1, 16); l1 += __shfl_xor(l1, 32);
    if (lane < 16) red[wave * 16 + lane] = l1;
    __threadfence();
    __syncthreads();
    __builtin_amdgcn_fence(__ATOMIC_ACQUIRE, "agent");
    LAS float* tot = (LAS float*)(shm + SCR_OFF);
    if (tid < 8) { float v = 0.f;
#pragma unroll
        for (int w = 0; w < 8; ++w) v += red[w * 16 + tid] + red[w * 16 + 8 + tid];
        tot[tid] = v; }
    __syncthreads();
    LAS c2* buf = (LAS c2*)shm + hb * FFT_PAD;
#pragma unroll 1
    for (int pr = 0; pr < 2; ++pr) { const int cc = 2 * pr + hb;
        const float inv0 = 0.5f / (tot[cc] * (float)N), inv1 = 0.5f / (tot[4 + cc] * (float)N);
        const c2* Z = KF0b + (size_t)cc * N;
#pragma unroll 8
        for (int i = ht; i < N; i += 256) buf[PHYS(i)] = Z[i];
        fft_fwd(buf, logN, tw, ht);
        c2* K0 = KF0b + (size_t)cc * N; c2* K1 = KF1b + (size_t)cc * N;
#pragma unroll 4
        for (int q = ht; q < N; q += 256) {
            const unsigned f = __brev((unsigned)q) >> (32 - logN);
            const unsigned q2 = __brev(((unsigned)N - f) & (unsigned)(N - 1)) >> (32 - logN);
            const c2 za = buf[PHYS(q)], zb = buf[PHYS((int)q2)];
            K0[q] = mkc2((za.x + zb.x) * inv0, (za.y - zb.y) * inv0);
            K1[q] = mkc2((za.y + zb.y) * inv1, (zb.x - za.x) * inv1); }
        __syncthreads(); }
}

__device__ __forceinline__ void xn_row(const float* hrow, const float* g, const float* shift, const float* scale, bf16_t* orow, int lane) {
    const float4* xr = (const float4*)hrow + lane;
    float4 v[8]; float s = 0.f;
#pragma unroll
    for (int j = 0; j < 8; ++j) { v[j] = xr[64 * j]; s += v[j].x * v[j].x + v[j].y * v[j].y + v[j].z * v[j].z + v[j].w * v[j].w; }
    const float r = rsqrtf(wave_sum(s) * (1.f / D) + 1e-6f);
    u32x2* o = (u32x2*)orow + lane;
#pragma unroll
    for (int j = 0; j < 8; ++j) { const float4 gg = ((const float4*)g)[lane + 64 * j], sh = ((const float4*)shift)[lane + 64 * j], sc = ((const float4*)scale)[lane + 64 * j];
        u32x2 w; w.x = cvt_pk_bf16(v[j].x * r * gg.x * (1.f + sc.x) + sh.x, v[j].y * r * gg.y * (1.f + sc.y) + sh.y);
        w.y = cvt_pk_bf16(v[j].z * r * gg.z * (1.f + sc.z) + sh.z, v[j].w * r * gg.w * (1.f + sc.w) + sh.w);
        o[64 * j] = w; }
}
__device__ __forceinline__ void xn_row1(PRef p, int layer, int which  , int row, int lane, const float* hL, const float* hC) {
    const float* mod = (const float*)(p.ws + O_MOD);
    const bool isc = row >= RL; const int mr = isc ? 4 : (row >> 12);
    const float* m = mod + (size_t)(layer * 5 + mr) * 12288 + (which ? 3 * 2048 : 0);
    const float* hrow = isc ? hC + (size_t)(row - RL) * 2048 : hL + (size_t)row * 2048;
    xn_row(hrow, p.in[which ? 29 : 6] + layer * 2048, m, m + 2048, (bf16_t*)(p.ws + O_XN) + (size_t)row * 2048, lane);
}

__device__ __forceinline__ void phase_lprep(PRef p, int layer, unsigned char* shm, const float* hL_, const float* hC_) {
    constexpr int N_S5 = 128, T_IN = 32 * 80, T_OUT = 32 * 32, T_UP = 32 * 176, T_DOWN = 88 * 32, T_GLU = 64;
    const int tid = otid(), wave = tid >> 6, lane = tid & 63, gw = blockIdx.x * 8 + wave, ngw = gridDim.x * 8;
    for (int rep = 0; rep < NREP(11); ++rep)
    for (int it = blockIdx.x; it < 384 + N_S5; it += gridDim.x) {
        int r = it;
        if (r >= 256 && r < 384) continue;
        if (r < 256) {
#if EN_HY
            const bool isctx = r >= 128; const int q = r & 127; if (!isctx || layer == 0) hyfilter_item(p, layer, isctx, q, shm);
#endif
            continue; }
        r -= 384;
#if EN_S5
        s5prep_item(p, layer, r >> 2, r & 3, shm);
#endif
    }
    __syncthreads();
    constexpr int NT = T_IN + T_OUT + T_UP + T_DOWN + T_GLU;
    for (int rep = 0; rep < NREP(12); ++rep)
    for (int it = gw; it < NT; it += ngw) {
        int r = it;
        if (r < T_IN) { convT_tile(p.in[7] + (size_t)layer * 2048 * 5120, 2048, 5120, (bf16_t*)(p.ws + O_WT_IN), r, shm, wave, lane); continue; } r -= T_IN;
        if (r < T_OUT) { convT_tile(p.in[28] + (size_t)layer * 2048 * 2048, 2048, 2048, (bf16_t*)(p.ws + O_WT_OUT), r, shm, wave, lane); continue; } r -= T_OUT;
        if (r < T_UP) { convT_tile(p.in[30] + (size_t)layer * 2048 * 11264, 2048, 11264, (bf16_t*)(p.ws + O_WT_UP), r, shm, wave, lane); continue; } r -= T_UP;
        if (r < T_DOWN) { convT_tile(p.in[33] + (size_t)layer * 5632 * 2048, 5632, 2048, (bf16_t*)(p.ws + O_WT_DOWN), r, shm, wave, lane); continue; } r -= T_DOWN;
        convT_tile(p.in[26] + (size_t)layer * 512 * 512, 512, 512, (bf16_t*)(p.ws + O_WT_GLU), r, shm, wave, lane);
    }
    for (int row = gw; row < RT; row += ngw) xn_row1(p, layer, 0, row, lane, hL_, hC_);
}

__device__ __forceinline__ void wave_sync_lds() { __builtin_amdgcn_fence(__ATOMIC_RELEASE, "wavefront"); __builtin_amdgcn_wave_barrier(); __builtin_amdgcn_fence(__ATOMIC_ACQUIRE, "wavefront"); }
__device__ __forceinline__ void hyT_witem(PRef p, int layer, bool isctx, int tile, unsigned char* shm, int wave, int lane) {
    const int L = isctx ? 256 : 4096, ntt = L / 32;
    const int b = tile / (ntt * 48), rem = tile % (ntt * 48), t0 = (rem / 48) * 32, c0 = (rem % 48) * 32;
    const bf16_t* A = (const bf16_t*)(p.ws + O_A) + (size_t)(isctx ? RL + b * 256 : b * 4096) * NIN;
    bf16_t* T = isctx ? (bf16_t*)(p.ws + O_HYTC) : (bf16_t*)(p.ws + O_HYT);
    float* X = (float*)shm + wave * (34 * 33);
#pragma unroll
    for (int i = 0; i < 3; ++i) { const int rr = 16 * i + (lane >> 2), c8 = (lane & 3) * 8, t = t0 - 1 + rr;
        if (rr < 34) { u32x4 v = (u32x4){0u, 0u, 0u, 0u};
            if (t >= 0 && t < L) v = *(const u32x4*)(A + (size_t)t * NIN + c0 + c8);
            float* d = X + rr * 33 + c8; d[0] = bflo(v.x); d[1] = bfhi(v.x); d[2] = bflo(v.y); d[3] = bfhi(v.y); d[4] = bflo(v.z); d[5] = bfhi(v.z); d[6] = bflo(v.w); d[7] = bfhi(v.w); } }
    wave_sync_lds();
    { const int cl = lane >> 1, t16 = (lane & 1) * 16, c = c0 + cl;
      const float w0 = p.in[8][(layer * 3 + 0) * 1536 + c], w1 = p.in[8][(layer * 3 + 1) * 1536 + c], w2 = p.in[8][(layer * 3 + 2) * 1536 + c], bb = p.in[9][layer * 1536 + c];
      float o[16];
#pragma unroll
      for (int j = 0; j < 16; ++j) { const int rr = t16 + j + 1; o[j] = w0 * X[(rr - 1) * 33 + cl] + w1 * X[rr * 33 + cl] + w2 * X[(rr + 1) * 33 + cl] + bb; }
      u32x4 wa, wb; wa.x = cvt_pk_bf16(o[0], o[1]); wa.y = cvt_pk_bf16(o[2], o[3]); wa.z = cvt_pk_bf16(o[4], o[5]); wa.w = cvt_pk_bf16(o[6], o[7]);
      wb.x = cvt_pk_bf16(o[8], o[9]); wb.y = cvt_pk_bf16(o[10], o[11]); wb.z = cvt_pk_bf16(o[12], o[13]); wb.w = cvt_pk_bf16(o[14], o[15]);
      bf16_t* dst = T + ((size_t)(b * 1536 + c)) * L + t0 + t16;
      *(u32x4*)dst = wa; *(u32x4*)(dst + 8) = wb; }
    wave_sync_lds();
}

constexpr int LDK = 136;
__device__ __forceinline__ void retkv_item(PRef p, int layer, int item, unsigned char* shm) {
    const int tid = otid(), lane = tid & 63, wave = tid >> 6, fr = lane & 15, fq = lane >> 4;
    int b, h, n, row0, cidx;
    if (item < 1024) { b = item >> 8; h = (item >> 5) & 7; n = item & 31; row0 = b * 4096 + n * 128; cidx = 2 + n; }
    else { const int q = item - 1024; b = q >> 4; h = (q >> 1) & 7; n = q & 1; row0 = RL + b * 256 + n * 128; cidx = n; }
    const float lgf = -expf(p.in[17][(layer * 2 + 0) * 8 + h]), lgb = -expf(p.in[17][(layer * 2 + 1) * 8 + h]);
    const bf16_t* A = (const bf16_t*)(p.ws + O_A);
    bf16_t* kTf = (bf16_t*)shm; bf16_t* kTb = kTf + 64 * LDK; bf16_t* vT = kTb + 64 * LDK;
#pragma unroll
    for (int i = 0; i < 2; ++i) { const int idx = tid + 512 * i, m = idx >> 3, d8 = (idx & 7) * 8;
        const u32x4 v = *(const u32x4*)(A + (size_t)(row0 + m) * NIN + C_K + h * 64 + d8);
        const float pf = 0.125f * expf((float)(127 - m) * lgf), pb = 0.125f * expf((float)m * lgb);
        const unsigned ww[4] = {v.x, v.y, v.z, v.w};
#pragma unroll
        for (int j = 0; j < 4; ++j) { const float lo = bflo(ww[j]), hi = bfhi(ww[j]);
            kTf[(d8 + 2 * j) * LDK + m] = f2bf(lo * pf); kTf[(d8 + 2 * j + 1) * LDK + m] = f2bf(hi * pf);
            kTb[(d8 + 2 * j) * LDK + m] = f2bf(lo * pb); kTb[(d8 + 2 * j + 1) * LDK + m] = f2bf(hi * pb); } }
#pragma unroll
    for (int i = 0; i < 4; ++i) { const int idx = tid + 512 * i, m = idx >> 4, e8 = (idx & 15) * 8;
        const u32x4 v = *(const u32x4*)(A + (size_t)(row0 + m) * NIN + C_V + h * 128 + e8);
        const unsigned ww[4] = {v.x, v.y, v.z, v.w};
#pragma unroll
        for (int j = 0; j < 4; ++j) { vT[(e8 + 2 * j) * LDK + m] = (bf16_t)(ww[j] & 0xffffu); vT[(e8 + 2 * j + 1) * LDK + m] = (bf16_t)(ww[j] >> 16); } }
    __syncthreads();
    const int dir = wave >> 2, mt = wave & 3;
    const bf16_t* kT = dir ? kTb : kTf;
    f32x4 acc[8];
#pragma unroll
    for (int nt = 0; nt < 8; ++nt) acc[nt] = (f32x4){0.f, 0.f, 0.f, 0.f};
#pragma unroll
    for (int kk = 0; kk < 4; ++kk) { const bf16x8 af = *(const bf16x8*)(kT + (16 * mt + fr) * LDK + kk * 32 + fq * 8);
#pragma unroll
        for (int nt = 0; nt < 8; ++nt) { const bf16x8 bf = *(const bf16x8*)(vT + (16 * nt + fr) * LDK + kk * 32 + fq * 8);
            acc[nt] = __builtin_amdgcn_mfma_f32_16x16x32_bf16(af, bf, acc[nt], 0, 0, 0); } }
    float* ST = (float*)(p.ws + O_RETST) + ((size_t)((b * 8 + h) * 2 + dir) * 34 + cidx) * 8192;
#pragma unroll
    for (int nt = 0; nt < 8; ++nt)
#pragma unroll
        for (int r = 0; r < 4; ++r) ST[(16 * mt + fq * 4 + r) * 128 + 16 * nt + fr] = acc[nt][r];
    __syncthreads();
}

__device__ __forceinline__ bf16x8 s5_ufrag(const bf16_t* A, int b, int g, int nt, int kk, int fr, int fq) {
    const int s = 2 * kk + (fq >> 1);
    const int row = (nt < 4) ? (b * 4096 + (16 * nt + fr) * 64 + s) : (RL + b * 256 + (fr & 3) * 64 + s);
    return *(const bf16x8*)(A + (size_t)row * NIN + C_U + g * 16 + (fq & 1) * 8);
}
constexpr int S5_UP = 2064;
__device__ __forceinline__ void s5_stage_u(const bf16_t* A, unsigned char* ul, int b, int g, int nt, int tid) {
#pragma unroll
    for (int i = 0; i < 4; ++i) { const int idx = tid + 512 * i, half = idx & 1, tok = (idx >> 1) & 63, ch = idx >> 7;
        const int row = (nt < 4) ? (b * 4096 + (16 * nt + ch) * 64 + tok) : (RL + b * 256 + (ch & 3) * 64 + tok);
        *(u32x4*)(ul + ch * S5_UP + tok * 32 + half * 16) = *(const u32x4*)(A + (size_t)row * NIN + C_U + g * 16 + half * 8); }
}
__device__ __forceinline__ void s5inc_item(PRef p, int item, unsigned char* shm) {
    const int tid = otid(), lane = tid & 63, wave = tid >> 6, fr = lane & 15, fq = lane >> 4;
    const int g = item >> 3, dir = (item >> 2) & 1, b = item & 3;
    const bf16_t* A = (const bf16_t*)(p.ws + O_A);
    const bf16_t* E = (const bf16_t*)(p.ws + O_S5E) + ((size_t)(dir * 32 + g) * 128 + 16 * wave + fr) * 1024 + fq * 8;
    bf16x8 af[32];
#pragma unroll
    for (int kk = 0; kk < 32; ++kk) af[kk] = *(const bf16x8*)(E + kk * 32);
    float* ST = (float*)(p.ws + O_S5ST) + (size_t)((g * 2 + dir) * 4 + b) * 68 * 128;
#pragma unroll 1
    for (int nt = 0; nt < 5; ++nt) {
        __syncthreads();
        s5_stage_u(A, shm, b, g, nt, tid);
        __syncthreads();
        f32x4 acc = (f32x4){0.f, 0.f, 0.f, 0.f};
#pragma unroll
        for (int kk = 0; kk < 32; ++kk) acc = __builtin_amdgcn_mfma_f32_16x16x32_bf16(af[kk], *(const bf16x8*)(shm + fr * S5_UP + kk * 64 + fq * 16), acc, 0, 0, 0);
        if (nt < 4 || fr < 4) { const int cidx = nt < 4 ? 4 + 16 * nt + fr : fr; *(f32x4*)(ST + (size_t)cidx * 128 + 16 * wave + fq * 4) = acc; }
    }
    __syncthreads();
}

__device__ __forceinline__ void phase_m1(PRef p, int layer, unsigned char* shm) {
    constexpr int N_RKV = 1088, N_S5I = 256;
    for (int it = blockIdx.x; it < N_S5I + N_RKV; it += gridDim.x) {
        int r = it;
        if (r < N_S5I) {
#if EN_S5
            for (int rep = 0; rep < NREP(8); ++rep) s5inc_item(p, r, shm);
#endif
            continue; }
        r -= N_S5I;
#if EN_RET
        for (int rep = 0; rep < NREP(9); ++rep) retkv_item(p, layer, r, shm);
#endif
    }
    __syncthreads();
#if EN_HY
    const int n_hyt = (layer == 0) ? 24576 + 1536 : 24576;
    const int tid = otid(), wave = tid >> 6, lane = tid & 63;
    { constexpr int delta = 4; const int per = (n_hyt / 8 + 64 * delta + 255) / 256, hv = per - delta > 0 ? per - delta : 0;
      const int b = blockIdx.x, mine = b < 64 ? hv : per, startw = b < 64 ? b * hv : 64 * hv + (b - 64) * per;
      const bool w256 = gridDim.x == 256;
      const int nk = w256 ? mine : (n_hyt + (int)gridDim.x * 8 - 1) / ((int)gridDim.x * 8);
      for (int k = 0; k < nk; ++k) { const int it = w256 ? (startw + k) * 8 + wave : (k * (int)gridDim.x + b) * 8 + wave; if (it >= n_hyt) break;
          if (it < 24576) hyT_witem(p, layer, false, it, shm, wave, lane); else hyT_witem(p, layer, true, it - 24576, shm, wave, lane); } }
#endif
}

__device__ __forceinline__ void unpack8(u32x4 v, float (&o)[8]) { o[0] = bflo(v.x); o[1] = bfhi(v.x); o[2] = bflo(v.y); o[3] = bfhi(v.y); o[4] = bflo(v.z); o[5] = bfhi(v.z); o[6] = bflo(v.w); o[7] = bfhi(v.w); }
__device__ __forceinline__ void hyconv_item(PRef p, int layer, bool isctx, int item, unsigned char* shm) {
    const int tid = otid(), hb = tid >> 8, ht = tid & 255;
    const int bp = item >> 8, c = 2 * (item & 255) + hb, b0 = 2 * bp, b1 = b0 + 1;
    const int L = isctx ? 256 : 4096, logN = isctx ? 9 : 13, N = 2 * L;
    LAS c2* buf = (LAS c2*)shm + hb * FFT_PAD;
    const LAS c2* tw = (const LAS c2*)(shm + SCR_OFF + SCR_TW);
    const bf16_t* T = isctx ? (const bf16_t*)(p.ws + O_HYTC) : (const bf16_t*)(p.ws + O_HYT);
    float* Y = isctx ? (float*)(p.ws + O_HYYC) : (float*)(p.ws + O_HYY);
    const c2* KF0 = isctx ? (const c2*)(p.ws + O_KFC) + (size_t)c * 512 : (const c2*)(p.ws + O_KF) + (size_t)c * 8192;
    const c2* KF1 = isctx ? (const c2*)(p.ws + O_KFC) + (size_t)(512 + c) * 512 : (const c2*)(p.ws + O_KF) + (size_t)(512 + c) * 8192;
    const bf16_t* v0 = T + (size_t)(b0 * 1536 + c) * L; const bf16_t* v1 = T + (size_t)(b1 * 1536 + c) * L;
    float* y0 = Y + (size_t)(b0 * 512 + c) * L; float* y1 = Y + (size_t)(b1 * 512 + c) * L;
    const float bias0 = p.in[16][(layer * 2 + 0) * 512 + c], bias1 = p.in[16][(layer * 2 + 1) * 512 + c];
    __syncthreads();
#pragma unroll 2
    for (int t8 = ht * 8; t8 < L; t8 += 2048) { float a[8], b[8]; unpack8(*(const u32x4*)(v0 + t8), a); unpack8(*(const u32x4*)(v1 + t8), b);
#pragma unroll
        for (int j = 0; j < 8; ++j) { buf[PHYS(t8 + j)] = mkc2(a[j], b[j]); buf[PHYS(t8 + j + L)] = mkc2(0.f, 0.f); } }
    fft_fwd(buf, logN, tw, ht);
#pragma unroll 8
    for (int i = ht; i < N; i += 256) buf[PHYS(i)] = cmul(buf[PHYS(i)], KF0[i]);
    fft_inv(buf, logN, tw, ht);
#pragma unroll 2
    for (int t8 = ht * 8; t8 < L; t8 += 2048) { float a[8], b[8], xa[8], xb[8];
        unpack8(*(const u32x4*)(v0 + t8), a); unpack8(*(const u32x4*)(v1 + t8), b);
        unpack8(*(const u32x4*)(v0 + (size_t)512 * L + t8), xa); unpack8(*(const u32x4*)(v1 + (size_t)512 * L + t8), xb);
        float za[8], zb[8];
#pragma unroll
        for (int j = 0; j < 8; ++j) { const c2 cv = buf[PHYS(t8 + j)]; za[j] = xa[j] * (cv.x + bias0 * a[j]); zb[j] = xb[j] * (cv.y + bias0 * b[j]);
            buf[PHYS(t8 + j)] = mkc2(za[j], zb[j]); buf[PHYS(t8 + j + L)] = mkc2(0.f, 0.f); }
        *(float4*)(y0 + t8) = make_float4(za[0], za[1], za[2], za[3]); *(float4*)(y0 + t8 + 4) = make_float4(za[4], za[5], za[6], za[7]);
        *(float4*)(y1 + t8) = make_float4(zb[0], zb[1], zb[2], zb[3]); *(float4*)(y1 + t8 + 4) = make_float4(zb[4], zb[5], zb[6], zb[7]); }
    fft_fwd(buf, logN, tw, ht);
#pragma unroll 8
    for (int i = ht; i < N; i += 256) buf[PHYS(i)] = cmul(buf[PHYS(i)], KF1[i]);
    fft_inv(buf, logN, tw, ht);
#pragma unroll 2
    for (int t8 = ht * 8; t8 < L; t8 += 2048) { float xa[8], xb[8];
        unpack8(*(const u32x4*)(v0 + (size_t)1024 * L + t8), xa); unpack8(*(const u32x4*)(v1 + (size_t)1024 * L + t8), xb);
        const float4 p0 = *(const float4*)(y0 + t8), p1 = *(const float4*)(y0 + t8 + 4), q0 = *(const float4*)(y1 + t8), q1 = *(const float4*)(y1 + t8 + 4);
        const float za[8] = {p0.x, p0.y, p0.z, p0.w, p1.x, p1.y, p1.z, p1.w}, zb[8] = {q0.x, q0.y, q0.z, q0.w, q1.x, q1.y, q1.z, q1.w};
        float oa[8], ob[8];
#pragma unroll
        for (int j = 0; j < 8; ++j) { const c2 cv = buf[PHYS(t8 + j)]; oa[j] = xa[j] * (cv.x + bias1 * za[j]); ob[j] = xb[j] * (cv.y + bias1 * zb[j]); }
        *(float4*)(y0 + t8) = make_float4(oa[0], oa[1], oa[2], oa[3]); *(float4*)(y0 + t8 + 4) = make_float4(oa[4], oa[5], oa[6], oa[7]);
        *(float4*)(y1 + t8) = make_float4(ob[0], ob[1], ob[2], ob[3]); *(float4*)(y1 + t8 + 4) = make_float4(ob[4], ob[5], ob[6], ob[7]); }
    __syncthreads();
}

__device__ __forceinline__ void phase_m2(PRef p, int layer, unsigned char* shm, bool scans) {
    const int gid = blockIdx.x * 512 + otid(), gsz = scans ? gridDim.x * 512 : 0x40000000;
#if EN_RET
    for (int ch = scans ? gid : 0x7fffffff - gsz; ch < 64 * 8192; ch += gsz) { const int bhd = ch >> 13, el = ch & 8191, dir = bhd & 1, h = (bhd >> 1) & 7;
        const float dec = expf(-128.f * expf(p.in[17][(layer * 2 + dir) * 8 + h]));
        float* base = (float*)(p.ws + O_RETST) + (size_t)bhd * 34 * 8192 + el;
        float inc[34];
#pragma unroll
        for (int sidx = 0; sidx < 34; ++sidx) { const int cidx = dir == 0 ? sidx : (sidx < 2 ? 1 - sidx : 35 - sidx); inc[sidx] = base[(size_t)cidx * 8192]; }
        float st = 0.f;
#pragma unroll
        for (int sidx = 0; sidx < 34; ++sidx) { const int cidx = dir == 0 ? sidx : (sidx < 2 ? 1 - sidx : 35 - sidx);
            base[(size_t)cidx * 8192] = st; st = dec * st + inc[sidx]; } }
#endif
#if EN_S5
    for (int ch = scans ? gid : 0x7fffffff - gsz; ch < 256 * 64; ch += gsz) { const int gdb = ch >> 6, pp = ch & 63, g = gdb >> 3, dir = (gdb >> 2) & 1;
        const c2 lt = ((const c2*)(p.ws + O_S5LT))[(dir * 32 + g) * 64 + pp];
        c2* base = (c2*)((float*)(p.ws + O_S5ST) + (size_t)gdb * 68 * 128) + pp;
        c2 st = mkc2(0.f, 0.f);
#pragma unroll 1
        for (int half = 0; half < 2; ++half) {
            c2 inc[34];
#pragma unroll
            for (int j = 0; j < 34; ++j) { const int sidx = half * 34 + j; const int cidx = dir == 0 ? sidx : (sidx < 4 ? 3 - sidx : 71 - sidx); inc[j] = base[(size_t)cidx * 64]; }
#pragma unroll
            for (int j = 0; j < 34; ++j) { const int sidx = half * 34 + j; const int cidx = dir == 0 ? sidx : (sidx < 4 ? 3 - sidx : 71 - sidx);
                base[(size_t)cidx * 64] = st; const c2 ns = cmul(lt, st); st = mkc2(ns.x + inc[j].x, ns.y + inc[j].y); } } }
#endif
#if EN_HY
    const int total = (layer == 0) ? 1024 : 512;
    for (int it = blockIdx.x; it < total; it += gridDim.x) { if (it < 512) hyconv_item(p, layer, false, it, shm); else hyconv_item(p, layer, true, it - 512, shm); }
#endif
}

__device__ __forceinline__ bf16x8 scale8(bf16x8 q, float s) {
    const u32x4 w = un8(q); u32x4 o;
    o.x = cvt_pk_bf16(bflo(w.x) * s, bfhi(w.x) * s); o.y = cvt_pk_bf16(bflo(w.y) * s, bfhi(w.y) * s);
    o.z = cvt_pk_bf16(bflo(w.z) * s, bfhi(w.z) * s); o.w = cvt_pk_bf16(bflo(w.w) * s, bfhi(w.w) * s);
    return mk8(o);
}
__device__ __forceinline__ void retout_item(PRef p, int layer, int item, unsigned char* shm) {
    const int tid = otid(), lane = tid & 63, wave = tid >> 6, fr = lane & 15, fq = lane >> 4;
    int b, h, n, row0, cidx;
    if (item < 1024) { b = item >> 8; h = (item >> 5) & 7; n = item & 31; row0 = b * 4096 + n * 128; cidx = 2 + n; }
    else { const int q = item - 1024; b = q >> 4; h = (q >> 1) & 7; n = q & 1; row0 = RL + b * 256 + n * 128; cidx = n; }
    const float lgf = -expf(p.in[17][(layer * 2 + 0) * 8 + h]), lgb = -expf(p.in[17][(layer * 2 + 1) * 8 + h]);
    const bf16_t* A = (const bf16_t*)(p.ws + O_A);
    bf16_t* MIX = (bf16_t*)(p.ws + O_XN);
    bf16_t* vT = (bf16_t*)shm;
    bf16_t* sTf = vT + 128 * LDK;
    bf16_t* sTb = sTf + 128 * 72;
    bf16_t* Pw = sTb + 128 * 72 + wave * 16 * LDK;
#pragma unroll
    for (int i = 0; i < 4; ++i) { const int idx = tid + 512 * i, m = idx >> 4, e8 = (idx & 15) * 8;
        const u32x4 v = *(const u32x4*)(A + (size_t)(row0 + m) * NIN + C_V + h * 128 + e8);
        const unsigned ww[4] = {v.x, v.y, v.z, v.w};
#pragma unroll
        for (int j = 0; j < 4; ++j) { vT[(e8 + 2 * j) * LDK + m] = (bf16_t)(ww[j] & 0xffffu); vT[(e8 + 2 * j + 1) * LDK + m] = (bf16_t)(ww[j] >> 16); } }
    { const float* SF = (const float*)(p.ws + O_RETST) + ((size_t)((b * 8 + h) * 2 + 0) * 34 + cidx) * 8192;
      const float* SB = (const float*)(p.ws + O_RETST) + ((size_t)((b * 8 + h) * 2 + 1) * 34 + cidx) * 8192;
#pragma unroll 4
      for (int i = 0; i < 16; ++i) { const int idx = tid + 512 * i, d = idx >> 7, e = idx & 127;
          sTf[e * 72 + d] = f2bf(SF[idx]); sTb[e * 72 + d] = f2bf(SB[idx]); } }
    __syncthreads();
    bf16x8 qa[2];
#pragma unroll
    for (int kk = 0; kk < 2; ++kk) qa[kk] = *(const bf16x8*)(A + (size_t)(row0 + 16 * wave + fr) * NIN + C_Q + h * 64 + kk * 32 + fq * 8);
#pragma unroll
    for (int nt = 0; nt < 8; ++nt) { f32x4 s = (f32x4){0.f, 0.f, 0.f, 0.f};
#pragma unroll
        for (int kk = 0; kk < 2; ++kk) { const bf16x8 kb = *(const bf16x8*)(A + (size_t)(row0 + 16 * nt + fr) * NIN + C_K + h * 64 + kk * 32 + fq * 8);
            s = __builtin_amdgcn_mfma_f32_16x16x32_bf16(qa[kk], kb, s, 0, 0, 0); }
        const int m = 16 * nt + fr;
#pragma unroll
        for (int r = 0; r < 4; ++r) { const int c = 16 * wave + fq * 4 + r; const float dd = (float)(c - m);
            const float dec = (m <= c) ? expf(dd * lgf) : expf(-dd * lgb);
            Pw[(fq * 4 + r) * LDK + m] = f2bf(s[r] * 0.125f * dec); } }
    __syncthreads();
    f32x4 acc[8];
#pragma unroll
    for (int et = 0; et < 8; ++et) acc[et] = (f32x4){0.f, 0.f, 0.f, 0.f};
#pragma unroll
    for (int kk = 0; kk < 4; ++kk) { const bf16x8 af = *(const bf16x8*)(Pw + fr * LDK + kk * 32 + fq * 8);
#pragma unroll
        for (int et = 0; et < 8; ++et) { const bf16x8 bf = *(const bf16x8*)(vT + (16 * et + fr) * LDK + kk * 32 + fq * 8);
            acc[et] = __builtin_amdgcn_mfma_f32_16x16x32_bf16(af, bf, acc[et], 0, 0, 0); } }
    { const int ca = 16 * wave + fr;
      const float sf = expf((float)(ca + 1) * lgf), sb = expf((float)(128 - ca) * lgb);
#pragma unroll
      for (int kk = 0; kk < 2; ++kk) { const bf16x8 af = scale8(qa[kk], sf), ab = scale8(qa[kk], sb);
#pragma unroll
          for (int et = 0; et < 8; ++et) { const bf16x8 b1 = *(const bf16x8*)(sTf + (16 * et + fr) * 72 + kk * 32 + fq * 8);
              acc[et] = __builtin_amdgcn_mfma_f32_16x16x32_bf16(af, b1, acc[et], 0, 0, 0);
              const bf16x8 b2 = *(const bf16x8*)(sTb + (16 * et + fr) * 72 + kk * 32 + fq * 8);
              acc[et] = __builtin_amdgcn_mfma_f32_16x16x32_bf16(ab, b2, acc[et], 0, 0, 0); } } }
#pragma unroll
    for (int r = 0; r < 4; ++r) { float ss = 0.f;
#pragma unroll
        for (int et = 0; et < 8; ++et) ss += acc[et][r] * acc[et][r];
        ss += __shfl_xor(ss, 1); ss += __shfl_xor(ss, 2); ss += __shfl_xor(ss, 4); ss += __shfl_xor(ss, 8);
        const float rinv = rsqrtf(ss * (1.f / 128.f) + 1e-6f);
        const size_t row = (size_t)(row0 + 16 * wave + fq * 4 + r);
#pragma unroll
        for (int et = 0; et < 8; ++et) { const int e = 16 * et + fr; const float gg = bf2f(A[row * NIN + C_G + h * 128 + e]);
            MIX[row * 2048 + 512 + h * 128 + e] = f2bf(acc[et][r] * rinv * gg * sigmoidf_(gg)); } }
    __syncthreads();
}

__device__ __forceinline__ void s5out_item(PRef p, int layer, int item, unsigned char* shm) {
    const int tid = otid(), lane = tid & 63, wave = tid >> 6, fr = lane & 15, fq = lane >> 4;
    const int g = item >> 3, b = (item >> 1) & 3, mh = item & 1;
    const bf16_t* A = (const bf16_t*)(p.ws + O_A);
    bf16_t* KT = (bf16_t*)shm;
    unsigned char* ul = shm + 65024;
    __syncthreads();
    { const u32x4* src = (const u32x4*)((const bf16_t*)(p.ws + O_S5K) + (size_t)g * 127 * 256); u32x4* dst = (u32x4*)shm;
      for (int i = tid; i < 127 * 256 / 8; i += 512) dst[i] = src[i]; }
    const int tb = 32 * mh + 4 * wave;
    bf16_t* Z = (bf16_t*)(p.ws + O_Z5);
    const f32x4 dv = *(const f32x4*)(p.in[25] + layer * 512 + g * 16 + fq * 4);
#pragma unroll 1
    for (int nt = 0; nt < 5; ++nt) {
        __syncthreads();
        s5_stage_u(A, ul, b, g, nt, tid);
        __syncthreads();
        f32x4 acc[4];
#pragma unroll
        for (int mi = 0; mi < 4; ++mi) acc[mi] = (f32x4){0.f, 0.f, 0.f, 0.f};
#pragma unroll 4
        for (int kk = 0; kk < 32; ++kk) {
            const bf16x8 bfr = *(const bf16x8*)(ul + fr * S5_UP + kk * 64 + fq * 16);
            const int sq = 2 * kk + (fq >> 1);
#pragma unroll
            for (int mi = 0; mi < 4; ++mi) { const bf16x8 af = *(const bf16x8*)(KT + (tb + mi - sq + 63) * 256 + fr * 16 + (fq & 1) * 8);
                acc[mi] = __builtin_amdgcn_mfma_f32_16x16x32_bf16(af, bfr, acc[mi], 0, 0, 0); } }
        const int cidx = nt < 4 ? 4 + 16 * nt + fr : (fr & 3);
#pragma unroll
        for (int dir = 0; dir < 2; ++dir) {
            const bf16_t* G = (const bf16_t*)(p.ws + O_S5G) + (size_t)(dir * 32 + g) * 1024 * 128;
            const float* ST = (const float*)(p.ws + O_S5ST) + (size_t)((g * 2 + dir) * 4 + b) * 68 * 128 + (size_t)cidx * 128;
#pragma unroll
            for (int kk = 0; kk < 4; ++kk) {
                const f32x4 x0 = *(const f32x4*)(ST + kk * 32 + fq * 8), x1 = *(const f32x4*)(ST + kk * 32 + fq * 8 + 4);
                u32x4 w; w.x = cvt_pk_bf16(x0[0], x0[1]); w.y = cvt_pk_bf16(x0[2], x0[3]); w.z = cvt_pk_bf16(x1[0], x1[1]); w.w = cvt_pk_bf16(x1[2], x1[3]);
                const bf16x8 bfr = mk8(w);
#pragma unroll
                for (int mi = 0; mi < 4; ++mi) { const bf16x8 af = *(const bf16x8*)(G + (size_t)((tb + mi) * 16 + fr) * 128 + kk * 32 + fq * 8);
                    acc[mi] = __builtin_amdgcn_mfma_f32_16x16x32_bf16(af, bfr, acc[mi], 0, 0, 0); } } }
        if (nt < 4 || fr < 4) {
#pragma unroll
            for (int mi = 0; mi < 4; ++mi) { const int t = tb + mi; const size_t row = nt < 4 ? (size_t)(b * 4096 + (16 * nt + fr) * 64 + t) : (size_t)(RL + b * 256 + fr * 64 + t);
                const u32x2 uu = *(const u32x2*)(ul + fr * S5_UP + t * 32 + fq * 8);
                const f32x4 y = acc[mi];
                u32x2 w; w.x = cvt_pk_bf16(gelu_tanh(y[0] + dv[0] * bflo(uu.x)), gelu_tanh(y[1] + dv[1] * bfhi(uu.x)));
                w.y = cvt_pk_bf16(gelu_tanh(y[2] + dv[2] * bflo(uu.y)), gelu_tanh(y[3] + dv[3] * bfhi(uu.y)));
                *(u32x2*)(Z + row * 512 + g * 16 + fq * 4) = w; } }
    }
    __syncthreads();
}

__device__ __forceinline__ void hyback_witem(PRef p, bool isctx, int tile, unsigned char* shm, int wave, int lane) {
    const int L = isctx ? 256 : 4096, ntt = L / 32;
    const int b = tile / (ntt * 16), rem = tile % (ntt * 16), t0 = (rem / 16) * 32, c0 = (rem % 16) * 32;
    const float* Y = isctx ? (const float*)(p.ws + O_HYYC) : (const float*)(p.ws + O_HYY);
    bf16_t* MIX = (bf16_t*)(p.ws + O_XN) + (size_t)(isctx ? RL + b * 256 : b * 4096) * 2048;
    float* T = (float*)shm + wave * (32 * 33);
    { const int cl = lane >> 1, t16 = (lane & 1) * 16; const float4* sp = (const float4*)(Y + (size_t)(b * 512 + c0 + cl) * L + t0 + t16);
      float* d = T + cl * 33 + t16;
#pragma unroll
      for (int q = 0; q < 4; ++q) { const float4 a = sp[q]; d[4 * q] = a.x; d[4 * q + 1] = a.y; d[4 * q + 2] = a.z; d[4 * q + 3] = a.w; } }
    wave_sync_lds();
    { const int tl = lane >> 1, c16 = (lane & 1) * 16; const float* sp = T + c16 * 33 + tl;
      u32x4 wa, wb;
      wa.x = cvt_pk_bf16(sp[0], sp[33]); wa.y = cvt_pk_bf16(sp[2 * 33], sp[3 * 33]); wa.z = cvt_pk_bf16(sp[4 * 33], sp[5 * 33]); wa.w = cvt_pk_bf16(sp[6 * 33], sp[7 * 33]);
      wb.x = cvt_pk_bf16(sp[8 * 33], sp[9 * 33]); wb.y = cvt_pk_bf16(sp[10 * 33], sp[11 * 33]); wb.z = cvt_pk_bf16(sp[12 * 33], sp[13 * 33]); wb.w = cvt_pk_bf16(sp[14 * 33], sp[15 * 33]);
      bf16_t* dst = MIX + (size_t)(t0 + tl) * 2048 + c0 + c16;
      *(u32x4*)dst = wa; *(u32x4*)(dst + 8) = wb; }
    wave_sync_lds();
}

__device__ __forceinline__ void zero_mix_cols(PRef p, int col0, int ncols) {
    bf16_t* MIX = (bf16_t*)(p.ws + O_XN);
    for (size_t i = (size_t)blockIdx.x * 512 + otid(); i < (size_t)RT * ncols; i += (size_t)gridDim.x * 512) MIX[(i / ncols) * 2048 + col0 + (i % ncols)] = 0;
}

__device__ __forceinline__ void phase_m3(PRef p, int layer, unsigned char* shm) {
    constexpr int N_S5O = 256, N_RO = 1088;
    for (int it = blockIdx.x; it < N_S5O + N_RO; it += gridDim.x) {
        int r = it;
        if (r < N_S5O) {
#if EN_S5
            for (int rep = 0; rep < NREP(8); ++rep) s5out_item(p, layer, r, shm);
#endif
            continue; }
        r -= N_S5O;
#if EN_RET
        for (int rep = 0; rep < NREP(9); ++rep) retout_item(p, layer, r, shm);
#endif
    }
    __syncthreads();
#if EN_HY
    const int n_hyb = (layer == 0) ? 8192 + 512 : 8192;
    const int tid = otid(), wave = tid >> 6, lane = tid & 63;
    { constexpr int delta = 4; const int per = (n_hyb / 8 + 64 * delta + 255) / 256, hv = per - delta > 0 ? per - delta : 0;
      const int b = blockIdx.x, mine = b < 64 ? hv : per, startw = b < 64 ? b * hv : 64 * hv + (b - 64) * per;
      const bool w256 = gridDim.x == 256;
      const int nk = w256 ? mine : (n_hyb + (int)gridDim.x * 8 - 1) / ((int)gridDim.x * 8);
      for (int k = 0; k < nk; ++k) { const int it = w256 ? (startw + k) * 8 + wave : (k * (int)gridDim.x + b) * 8 + wave; if (it >= n_hyb) break;
          if (it < 8192) hyback_witem(p, false, it, shm, wave, lane); else hyback_witem(p, true, it - 8192, shm, wave, lane); } }
#else
    zero_mix_cols(p, 0, 512);
#endif
#if !EN_RET
    zero_mix_cols(p, 512, 1024);
#endif
#if !EN_S5
    zero_mix_cols(p, 1536, 512);
#endif
}

__device__ __forceinline__ void phase_conv(PRef p, int layer, int nseg) {
    const int tid = otid(), fg = tid & 63, xs = tid >> 6;
    bf16_t* GV = (bf16_t*)(p.ws + O_GV);
    const float* CW = p.in[31] + (size_t)layer * 9 * NFF; const float* CB = p.in[32] + (size_t)layer * NFF;
    for (int it = blockIdx.x; it < nseg * 11; it += gridDim.x) {
        const int seg = it / 11, f = (it % 11) * 512 + fg * 8;
        const bool isc = seg >= 256;
        float w[9][8], bias[8];
#pragma unroll
        for (int k = 0; k < 9; ++k) { const float4 a = *(const float4*)(CW + (size_t)k * NFF + f), bq = *(const float4*)(CW + (size_t)k * NFF + f + 4);
            w[k][0] = a.x; w[k][1] = a.y; w[k][2] = a.z; w[k][3] = a.w; w[k][4] = bq.x; w[k][5] = bq.y; w[k][6] = bq.z; w[k][7] = bq.w; }
        { const float4 a = *(const float4*)(CB + f), bq = *(const float4*)(CB + f + 4); bias[0] = a.x; bias[1] = a.y; bias[2] = a.z; bias[3] = a.w; bias[4] = bq.x; bias[5] = bq.y; bias[6] = bq.z; bias[7] = bq.w; }
        int W, x0; const bf16_t* lp[3]; bool lv[3];
        if (!isc) { const int b = seg >> 6, r = seg & 63; W = 64; x0 = 8 * xs;
#pragma unroll
            for (int ky = 0; ky < 3; ++ky) { const int yy = r + ky - 1; lv[ky] = (yy >= 0) && (yy < 64); lp[ky] = GV + ((size_t)b * 4096 + (size_t)(lv[ky] ? yy : r) * 64) * NUP + f; } }
        else { const int s2 = seg - 256, b = s2 >> 2, q = s2 & 3; W = 256; x0 = q * 64 + 8 * xs;
#pragma unroll
            for (int ky = 0; ky < 3; ++ky) { lv[ky] = (ky == 1); lp[ky] = GV + ((size_t)RL + b * 256) * NUP + f; } }
#pragma unroll 1
        for (int hx = 0; hx < 2; ++hx) { const int xb = x0 + 4 * hx;
            u32x4 gc[3][6], vv[4];
#pragma unroll
            for (int ky = 0; ky < 3; ++ky)
#pragma unroll
                for (int cx = 0; cx < 6; ++cx) { const int xx = xb - 1 + cx;
                    gc[ky][cx] = (lv[ky] && xx >= 0 && xx < W) ? *(const u32x4*)(lp[ky] + (size_t)xx * NUP) : (u32x4){0u, 0u, 0u, 0u}; }
#pragma unroll
            for (int xi = 0; xi < 4; ++xi) vv[xi] = *(const u32x4*)(lp[1] + (size_t)(xb + xi) * NUP + NFF);
#pragma unroll
            for (int xi = 0; xi < 4; ++xi) {
                float acc[8];
#pragma unroll
                for (int j = 0; j < 8; ++j) acc[j] = bias[j];
#pragma unroll
                for (int ky = 0; ky < 3; ++ky)
#pragma unroll
                    for (int kx = 0; kx < 3; ++kx) { const u32x4 gq = gc[ky][xi + kx]; const int k = ky * 3 + kx;
                        acc[0] += w[k][0] * bflo(gq.x); acc[1] += w[k][1] * bfhi(gq.x); acc[2] += w[k][2] * bflo(gq.y); acc[3] += w[k][3] * bfhi(gq.y);
                        acc[4] += w[k][4] * bflo(gq.z); acc[5] += w[k][5] * bfhi(gq.z); acc[6] += w[k][6] * bflo(gq.w); acc[7] += w[k][7] * bfhi(gq.w); }
                u32x4 o;
                o.x = cvt_pk_bf16(gelu_tanh(acc[0]) * bflo(vv[xi].x), gelu_tanh(acc[1]) * bfhi(vv[xi].x));
                o.y = cvt_pk_bf16(gelu_tanh(acc[2]) * bflo(vv[xi].y), gelu_tanh(acc[3]) * bfhi(vv[xi].y));
                o.z = cvt_pk_bf16(gelu_tanh(acc[4]) * bflo(vv[xi].z), gelu_tanh(acc[5]) * bfhi(vv[xi].z));
                o.w = cvt_pk_bf16(gelu_tanh(acc[6]) * bflo(vv[xi].w), gelu_tanh(acc[7]) * bfhi(vv[xi].w));
                *(u32x4*)((bf16_t*)lp[1] + (size_t)(xb + xi) * NUP + NFF) = o; } }
    }
}

__device__ __forceinline__ void final_norm_phase(const float* h, const float* g, float* out) {
    const int lane = otid() & 63, gw = blockIdx.x * 8 + (otid() >> 6), ngw = gridDim.x * 8;
    for (int row = gw; row < RL; row += ngw) {
        const float4* xr = (const float4*)(h + (size_t)row * D) + lane;
        float4 v[8]; float s = 0.f;
#pragma unroll
        for (int j = 0; j < 8; ++j) { v[j] = xr[64 * j]; s += v[j].x * v[j].x + v[j].y * v[j].y + v[j].z * v[j].z + v[j].w * v[j].w; }
        const float r = rsqrtf(wave_sum(s) * (1.f / D) + 1e-6f);
        float4* o = (float4*)(out + (size_t)row * D) + lane;
#pragma unroll
        for (int j = 0; j < 8; ++j) { const float4 gg = ((const float4*)g)[lane + 64 * j]; float4 w; w.x = v[j].x * r * gg.x; w.y = v[j].y * r * gg.y; w.z = v[j].z * r * gg.z; w.w = v[j].w * r * gg.w; o[64 * j] = w; }
    }
}

__device__ __forceinline__ void gbar(unsigned char* ws, unsigned k) {
    unsigned* base = (unsigned*)(ws + O_BAR);
    asm volatile("s_waitcnt vmcnt(0) lgkmcnt(0)" ::: "memory");
    __syncthreads();
    if (otid() == 0) {
        const unsigned g = blockIdx.x & 15u, ng = gridDim.x >> 4;
        __builtin_amdgcn_fence(__ATOMIC_RELEASE, "agent");
        const unsigned old = __hip_atomic_fetch_add(base + g * 32, 1u, __ATOMIC_RELAXED, __HIP_MEMORY_SCOPE_AGENT);
        if (old + 1u == k * ng) {
            const unsigned ot = __hip_atomic_fetch_add(base + 1024, 1u, __ATOMIC_RELAXED, __HIP_MEMORY_SCOPE_AGENT);
            if (ot + 1u == k * 16u) { for (unsigned gg = 0; gg < 16u; ++gg) __hip_atomic_store(base + 512 + gg * 32, k, __ATOMIC_RELAXED, __HIP_MEMORY_SCOPE_AGENT); }
        }
        while (__hip_atomic_load(base + 512 + g * 32, __ATOMIC_RELAXED, __HIP_MEMORY_SCOPE_AGENT) < k) __builtin_amdgcn_s_sleep(1);
        __builtin_amdgcn_fence(__ATOMIC_ACQUIRE, "agent");
    }
    __syncthreads();
}
__global__ void __launch_bounds__(512, 2) fwd_megakernel(Params p_) {
    extern __shared__ __attribute__((aligned(16))) unsigned char shm[];
    cg::grid_group grid = cg::this_grid();
    LAS unsigned char* lds = (LAS unsigned char*)shm;
#define mod ((const float*)(getp().ws + O_MOD))
#define hctx ((float*)(getp().ws + O_HCTX))
#define XN ((bf16_t*)(getp().ws + O_XN))
#define Abuf ((bf16_t*)(getp().ws + O_A))
#define GV ((bf16_t*)(getp().ws + O_GV))
    pg8::StaticOrder S;
    unsigned bar_n = 0;
#define GBAR() do { bar_n += 1u; gbar(getp().ws, bar_n); } while (0)
    { const int tid = otid();
      if (tid < 128) { const int e = tid < 64 ? tid << 6 : tid - 64; float sn, cs; sincospif((float)e * (1.f / 4096.f), &sn, &cs); ((LAS c2*)(shm + SCR_OFF + SCR_TW))[tid] = mkc2(cs, -sn); }
      __syncthreads(); }

    for (int rep = 0; rep < NREP(0); ++rep) { phase_p0(getp(), shm); grid.sync(); }
    for (int rep = 0; rep < ((REP_MASK >> 13) & 1) * 24; ++rep) GBAR();
#pragma unroll 1
    for (int layer = 0; layer < 2; ++layer) {
        const bool last = layer == 1;
#define hL (layer == 0 ? getp().in[0] : (const float*)getp().out)
#define hC (layer == 0 ? getp().in[2] : (const float*)hctx)
        const int Mrest = last ? RL : RT;
        for (int rep = 0; rep < NREP(1); ++rep) { phase_lprep(getp(), layer, shm, hL, hC); GBAR(); }
        { pg8::Gemm g{XN, (const bf16_t*)(getp().ws + O_WT_IN), RT, NIN, 2048, 2048, 2048}; S.init(g.M, g.N, gridDim.x, blockIdx.x);
          EpiStoreBf16 E{Abuf, NIN}; GEMM_REP(pg8::gemm_phase(lds, g, S, E); GBAR();) }
        for (int rep = 0; rep < NREP(3); ++rep) { phase_m1(getp(), layer, shm); GBAR(); }
        phase_m2(getp(), layer, shm, true);
        GBAR();
        for (int rep = 1; rep < NREP(4); ++rep) { phase_m2(getp(), layer, shm, false); GBAR(); }
        for (int rep = 0; rep < NREP(5); ++rep) { phase_m3(getp(), layer, shm); GBAR(); }
        { pg8::Gemm g{(const bf16_t*)(getp().ws + O_Z5), (const bf16_t*)(getp().ws + O_WT_GLU), RT, 512, 512, 512, 512}; S.init(g.M, g.N, gridDim.x, blockIdx.x);
          EpiGlu E{(const bf16_t*)(getp().ws + O_Z5), XN, getp().in[27] + layer * 512};
          GEMM_REP(pg8::gemm_phase(lds, g, S, E); GBAR();)
        }
        { pg8::Gemm g{XN, (const bf16_t*)(getp().ws + O_WT_OUT), RL, 2048, 2048, 2048, 2048}; S.init(g.M, g.N, gridDim.x, blockIdx.x);
          EpiResid E{hL, hC, getp().out, hctx, mod + (size_t)layer * 5 * 12288 + 2 * 2048}; pg8::gemm_phase(lds, g, S, E); }
        if (layer == 0) {
            for (int L2 = blockIdx.x; L2 < 256; L2 += gridDim.x) { const int part = L2 & 7, uu = L2 >> 3; pg8::SingleOrder S1{RL / 256 + (uu & 3), uu >> 2, true};
            pg8::Gemm g{XN + part * 256, (const bf16_t*)(getp().ws + O_WT_OUT) + part * 256, RT, 2048, 256, 2048, 2048};
            EpiResidAtomic E{hctx, mod + (size_t)(layer * 5 + 4) * 12288 + 2 * 2048}; pg8::gemm_phase(lds, g, S1, E); }
        }
        GBAR();
        { const int tid = otid(); for (int row = blockIdx.x * 8 + (tid >> 6); row < Mrest; row += gridDim.x * 8) xn_row1(getp(), layer, 1, row, tid & 63, getp().out, hctx); }
        GBAR();
        for (int rep = 1; rep < NREP(6); ++rep) { const int tid = otid(); for (int row = blockIdx.x * 8 + (tid >> 6); row < Mrest; row += gridDim.x * 8) xn_row1(getp(), layer, 1, row, tid & 63, getp().out, hctx); GBAR(); }
        { pg8::Gemm g{XN, (const bf16_t*)(getp().ws + O_WT_UP), Mrest, NUP, 2048, 2048, 2048}; S.init(g.M, g.N, gridDim.x, blockIdx.x);
          EpiStoreBf16 E{GV, NUP};
          pg8::gemm_phase(lds, g, S, E);
          GBAR(); }
        phase_conv(getp(), layer, last ? 256 : 272);
        GBAR();
        { pg8::Gemm g{GV + NFF, (const bf16_t*)(getp().ws + O_WT_DOWN), RL, 2048, NFF, NUP, NFF}; S.init(g.M, g.N, gridDim.x, blockIdx.x);
          EpiResid E{getp().out, hctx, getp().out, hctx, mod + (size_t)layer * 5 * 12288 + 5 * 2048}; pg8::gemm_phase(lds, g, S, E); }
        if (layer == 0) {
            for (int L2 = blockIdx.x; L2 < 128; L2 += gridDim.x) { const int part = L2 & 3, uu = L2 >> 2; pg8::SingleOrder S1{RL / 256 + (uu & 3), (uu >> 2) & 7, true};
            pg8::Gemm g{GV + NFF + part * 1408, (const bf16_t*)(getp().ws + O_WT_DOWN) + part * 1408, RT, 2048, 1408, NUP, NFF};
            EpiResidAtomic E{hctx, mod + (size_t)(layer * 5 + 4) * 12288 + 5 * 2048}; pg8::gemm_phase(lds, g, S1, E); }
        }
        GBAR();
    }
    final_norm_phase(getp().out, getp().in[34], getp().out);
}

extern "C" void kernel_launch(void* const* d_in, const int* in_sizes, int n_in, void* d_out, int out_size, void* d_ws, size_t ws_size, hipStream_t stream) {
    static int grid_blocks = 0;
    if (grid_blocks == 0) {
        int dev = 0, cus = 0, per_cu = 0;
        (void)hipGetDevice(&dev);
        (void)hipDeviceGetAttribute(&cus, hipDeviceAttributeMultiprocessorCount, dev);
        if (hipFuncSetAttribute((const void*)fwd_megakernel, hipFuncAttributeMaxDynamicSharedMemorySize, LDS_BYTES) != hipSuccess) fprintf(stderr, "hipFuncSetAttribute failed\n");
        (void)hipOccupancyMaxActiveBlocksPerMultiprocessor(&per_cu, (const void*)fwd_megakernel, 512, LDS_BYTES);
        (void)hipGetLastError();
        grid_blocks = cus & ~15;
        if (n_in != 35 || ws_size < O_END2) { fprintf(stderr, "kernel_launch: unexpected n_in %d or workspace %zu < %zu\n", n_in, ws_size, (size_t)O_END2); grid_blocks = -1; }
    }
    if (grid_blocks < 0) return;
    Params p{};
    for (int i = 0; i < 35; ++i) p.in[i] = (const float*)d_in[i];
    p.out = (float*)d_out; p.ws = (unsigned char*)d_ws; p.ws_size = (unsigned long long)ws_size;
    void* args[] = {&p};
    hipError_t e = hipLaunchCooperativeKernel((const void*)fwd_megakernel, dim3(grid_blocks), dim3(512), args, LDS_BYTES, stream);
    if (e != hipSuccess) fprintf(stderr, "cooperative launch failed: %s (grid %d)\n", hipGetErrorString(e), grid_blocks);
}
```

```cpp
#include <hip/hip_runtime.h>
#include <hip/hip_cooperative_groups.h>
#include <cstdio>
namespace cg = cooperative_groups;

#define LAS __attribute__((address_space(3)))
typedef unsigned short bf16_t;
typedef short bf16x8 __attribute__((ext_vector_type(8)));
typedef float f32x4 __attribute__((ext_vector_type(4)));
typedef unsigned u32x4 __attribute__((ext_vector_type(4)));
typedef unsigned u32x2 __attribute__((ext_vector_type(2)));
typedef float c2 __attribute__((ext_vector_type(2)));

#ifndef REP_MASK
#define REP_MASK 0
#endif
#define NREP(bit) ((REP_MASK >> (bit)) & 1 ? 2 : 1)
#if (REP_MASK >> 2) & 1
#define GEMM_REP(stmt) stmt stmt
#else
#define GEMM_REP(stmt) stmt
#endif
#ifndef EN_RET
#define EN_RET 1
#endif
#ifndef EN_S5
#define EN_S5 1
#endif
#ifndef EN_HY
#define EN_HY 1
#endif

struct Params {
    const float* in[35];
    float* out;
    unsigned char* ws;
    unsigned long long ws_size;
};

typedef const __attribute__((address_space(4))) Params& PRef;
__device__ __forceinline__ PRef getp() { const __attribute__((address_space(4))) Params* kp = (const __attribute__((address_space(4))) Params*)__builtin_amdgcn_kernarg_segment_ptr(); asm volatile("" : "+s"(kp)); return *kp; }
constexpr int D = 2048, NB = 4, SEQ = 4096, LC = 256, RL = NB * SEQ, RC = NB * LC, RT = RL + RC;
constexpr int NIN = 5120, NFF = 5632, NUP = 11264;
constexpr int C_Q = 1536, C_K = 2048, C_V = 2560, C_G = 3584, C_U = 4608;
constexpr int LDS_BYTES = 143360, SCR_OFF = 139264, SCR_WCOL = 64, SCR_TW = 1088, FFT_PAD = 8704;

constexpr size_t al256(size_t x) { return (x + 255) & ~(size_t)255; }
constexpr size_t O_WT_IN = 0;
constexpr size_t O_WT_OUT = O_WT_IN + (size_t)5120 * 2048 * 2;
constexpr size_t O_WT_UP = O_WT_OUT + (size_t)2048 * 2048 * 2;
constexpr size_t O_WT_DOWN = O_WT_UP + (size_t)11264 * 2048 * 2;
constexpr size_t O_WT_GLU = O_WT_DOWN + (size_t)2048 * 5632 * 2;
constexpr size_t O_HCTX = O_WT_GLU + (size_t)512 * 512 * 2;
constexpr size_t O_MOD = O_HCTX + (size_t)RC * 2048 * 4;
constexpr size_t O_HID = O_MOD + al256((size_t)2 * 5 * 12288 * 4);
constexpr size_t O_TW = O_HID + (size_t)2 * 4352 * 64 * 4;
constexpr size_t O_KF = O_TW + 4096 * 8;
constexpr size_t O_KFC = O_KF + (size_t)2 * 512 * 8192 * 8;
constexpr size_t O_S5E = O_KFC + (size_t)2 * 512 * 512 * 8;
constexpr size_t O_S5G = O_S5E + (size_t)64 * 128 * 1024 * 2;
constexpr size_t O_S5K = O_S5G + (size_t)64 * 1024 * 128 * 2;
constexpr size_t O_S5LT = O_S5K + al256((size_t)32 * 127 * 256 * 2);
constexpr size_t O_XN = O_S5LT + 64 * 64 * 8;
constexpr size_t O_U = O_XN + (size_t)RT * 2048 * 2;
constexpr size_t O_A = O_U;
constexpr size_t O_HYT = O_A + (size_t)RT * 5120 * 2;
constexpr size_t O_HYTC = O_HYT + (size_t)4 * 1536 * 4096 * 2;
constexpr size_t O_HYY = O_HYTC + (size_t)4 * 1536 * 256 * 2;
constexpr size_t O_HYYC = O_HYY + (size_t)4 * 512 * 4096 * 4;
constexpr size_t O_Z5 = O_HYYC + (size_t)4 * 512 * 256 * 4;
constexpr size_t O_RETST = O_Z5 + (size_t)RT * 512 * 2;
constexpr size_t O_S5ST = O_RETST + (size_t)64 * 34 * 8192 * 4;
constexpr size_t O_MIXEND = O_S5ST + (size_t)256 * 68 * 128 * 4;
constexpr size_t O_GV = O_U;
constexpr size_t O_END = O_GV + (size_t)RT * 11264 * 2;
static_assert(O_MIXEND <= O_END, "mixer buffers must fit in the union region");
constexpr size_t O_QCTR = O_END;
constexpr size_t O_BAR = O_QCTR + 256;
constexpr size_t O_END2 = O_BAR + 8192;

__device__ __forceinline__ int otid() { int t = (int)__builtin_amdgcn_workitem_id_x(); asm volatile("" : "+v"(t)); return t; }
__device__ __forceinline__ unsigned cvt_pk_bf16(float lo, float hi) { unsigned r; asm("v_cvt_pk_bf16_f32 %0, %1, %2" : "=v"(r) : "v"(lo), "v"(hi)); return r; }
__device__ __forceinline__ float bf2f(unsigned short b) { return __uint_as_float(((unsigned)b) << 16); }
__device__ __forceinline__ float bflo(unsigned w) { return __uint_as_float(w << 16); }
__device__ __forceinline__ float bfhi(unsigned w) { return __uint_as_float(w & 0xffff0000u); }
__device__ __forceinline__ unsigned short f2bf(float f) { return (unsigned short)(cvt_pk_bf16(f, 0.f) & 0xffffu); }
__device__ __forceinline__ float sigmoidf_(float x) { return 1.f / (1.f + __expf(-x)); }
__device__ __forceinline__ float gelu_tanh(float x) { const float u = 0.7978845608028654f * (x + 0.044715f * x * x * x); return x / (1.f + __expf(-2.f * u)); }
__device__ __forceinline__ float wave_sum(float v) {
#pragma unroll
    for (int o = 1; o < 64; o <<= 1) v += __shfl_xor(v, o);
    return v;
}
__device__ __forceinline__ c2 mkc2(float x, float y) { c2 r; r.x = x; r.y = y; return r; }
__device__ __forceinline__ c2 cmul(c2 a, c2 b) { return mkc2(a.x * b.x - a.y * b.y, a.x * b.y + a.y * b.x); }
__device__ __forceinline__ c2 cmulc(c2 a, c2 b) { return mkc2(a.x * b.x + a.y * b.y, a.y * b.x - a.x * b.y); }
__device__ __forceinline__ bf16x8 mk8(u32x4 w) { union { u32x4 u; bf16x8 b; } x; x.u = w; return x.b; }
__device__ __forceinline__ u32x4 un8(bf16x8 b) { union { u32x4 u; bf16x8 b; } x; x.b = b; return x.u; }

namespace pg8 {
constexpr int BM = 256, BK = 64, HALF = 128, HTB = HALF * BK * 2, STAGE_BYTES = 8 * HTB, NXCD = 8, WGM = 8;
__host__ __device__ __forceinline__ int lds_byte(int r, int c) { const int st = (r >> 4) * 2 + (c >> 5), rr = r & 15, cc = c & 31, ob = rr * 64 + cc * 2; return st * 1024 + (ob ^ (((ob >> 9) & 1) << 5)); }
__host__ __device__ __forceinline__ void stage_rc(int b, int& R, int& C) { const int st = b / 1024, sb = b % 1024, swz = sb ^ (((sb >> 9) & 1) << 5); R = (st >> 1) * 16 + swz / 64; C = (st & 1) * 32 + (swz % 64) / 2; }
__host__ __device__ __forceinline__ int perm32(int rho) { const int n = rho >> 4, i = rho & 15; return 8 * (i >> 2) + 4 * n + (i & 3); }
struct Unit { int pm, pn; };
struct Gemm { const bf16_t* A; const bf16_t* Bt; int M, N, K, lda, ldb; };
struct StaticOrder {
    int nM, nN, nwg, G, c;
    __device__ void init(int M, int N, int G_, int c_) { nM = M / BM; nN = N / BM; nwg = nM * nN; G = G_; c = c_; }
    __device__ bool next(int i, Unit& u) const {
        const long L = (long)i * G + c; if (L >= nwg) return false;
        int wgid = (int)L; { const int q = nwg / NXCD, r = nwg % NXCD, xcd = wgid % NXCD, off = wgid / NXCD; wgid = (xcd < r ? xcd * (q + 1) : r * (q + 1) + (xcd - r) * q) + off; }
        const int nig = WGM * nN, gid = wgid / nig, fm = gid * WGM, gsz = (nM - fm) < WGM ? (nM - fm) : WGM;
        u.pm = fm + ((wgid % nig) % gsz); u.pn = (wgid % nig) / gsz; return true;
    }
};

struct SingleOrder { int pm, pn; bool has; __device__ __forceinline__ bool next(int i, Unit& u) const { u.pm = pm; u.pn = pn; return has && i == 0; } };
template <class Epi, class Sched>
__device__ __forceinline__ void gemm_phase(LAS unsigned char* lds, const Gemm g, const Sched& S, const Epi& E) {
    const int tid = otid(), wid = __builtin_amdgcn_readfirstlane(tid >> 6), lane = tid & 63, wr = wid >> 2, wc = wid & 3, fr = lane & 15, fq = lane >> 4;
    const int K = g.K, nt = K / BK, lda = g.lda, ldb = g.ldb;
    unsigned voffA, voffB;
    { int R, C; stage_rc(tid * 16, R, C); const int Rb = Epi::PERM ? ((R & ~31) + perm32(R & 31)) : R;
      voffA = (unsigned)(R * lda + C) * 2u; voffB = (unsigned)(Rb * ldb + C) * 2u; }
    const size_t r64voffA = (size_t)64 * lda * 2, r64voffB = (size_t)64 * ldb * 2;
    const size_t kstep = (size_t)(BK * 2);
    const size_t hstepA = (size_t)HALF * lda * 2, hstepB = (size_t)HALF * ldb * 2;
    const size_t tstepA = 2 * hstepA, tstepB = 2 * hstepB;
    const unsigned ldsw = (unsigned)wid * 1024u;
    const int aoff = lds_byte(wr * 64 + fr, fq * 8), boff = lds_byte(wc * 32 + fr, fq * 8);
#define PG8_SA(b, h) (((b) * 2 + (h)) * HTB)
#define PG8_SB(b, h) ((4 + (b) * 2 + (h)) * HTB)
#define PG8_STAGE(bufoff, gbase, voff) do { _Pragma("unroll") for (int _i = 0; _i < 2; ++_i) \
        __builtin_amdgcn_global_load_lds((const unsigned*)((const char*)(gbase) + (size_t)_i * r64##voff + (voff)), (LAS unsigned*)(lds + (bufoff) + ldsw + _i * 8192), 16, 0, 0); } while (0)
#define PG8_LDA(dst, b, h) do { _Pragma("unroll") for (int m = 0; m < 4; ++m) _Pragma("unroll") for (int k = 0; k < 2; ++k) dst[m][k] = *(const LAS bf16x8*)(lds + PG8_SA(b, h) + aoff + m * 2048 + k * 1024); } while (0)
#define PG8_LDB(dst, b, h) do { _Pragma("unroll") for (int n = 0; n < 2; ++n) _Pragma("unroll") for (int k = 0; k < 2; ++k) dst[n][k] = *(const LAS bf16x8*)(lds + PG8_SB(b, h) + boff + n * 2048 + k * 1024); } while (0)
#define PG8_MMA(ai, bj, At, Bt) do { __builtin_amdgcn_s_setprio(1); _Pragma("unroll") for (int m = 0; m < 4; ++m) _Pragma("unroll") for (int n = 0; n < 2; ++n) _Pragma("unroll") for (int k = 0; k < 2; ++k) \
        acc[ai][bj][m][n] = __builtin_amdgcn_mfma_f32_16x16x32_bf16(Bt[n][k], At[m][k], acc[ai][bj][m][n], 0, 0, 0); __builtin_amdgcn_s_setprio(0); } while (0)
#define PG8_WAIT_V(n) asm volatile("s_waitcnt vmcnt(" #n ")" ::: "memory")
#define PG8_WAIT_L(n) asm volatile("s_waitcnt lgkmcnt(" #n ")" ::: "memory")
#define PG8_BAR __builtin_amdgcn_s_barrier()
#define PG8_SCHED __builtin_amdgcn_sched_barrier(0)
    Unit cur, nxt; int ui = 0;
    if (!S.next(0, cur)) return;
    f32x4 acc[2][2][4][2];
#pragma unroll
    for (int a = 0; a < 2; ++a)
#pragma unroll
        for (int b = 0; b < 2; ++b)
#pragma unroll
            for (int m = 0; m < 4; ++m)
#pragma unroll
                for (int n = 0; n < 2; ++n) acc[a][b][m][n] = (f32x4){0.f, 0.f, 0.f, 0.f};
    bf16x8 At[4][2], B0[2][2], B1[2][2];
    const char* cA = (const char*)g.A + (size_t)cur.pm * tstepA; const char* cB = (const char*)g.Bt + (size_t)cur.pn * tstepB;
    PG8_STAGE(PG8_SB(0, 0), cB, voffB); PG8_STAGE(PG8_SA(0, 0), cA, voffA); PG8_STAGE(PG8_SB(0, 1), cB + hstepB, voffB); PG8_STAGE(PG8_SA(0, 1), cA + hstepA, voffA);
    if (wr == 1) PG8_BAR;
    PG8_WAIT_V(4); PG8_BAR;
    PG8_STAGE(PG8_SB(1, 0), cB + kstep, voffB); PG8_STAGE(PG8_SA(1, 0), cA + kstep, voffA); PG8_STAGE(PG8_SB(1, 1), cB + hstepB + kstep, voffB);
    PG8_WAIT_V(6); PG8_BAR;
    for (;;) {
        const bool has_next = S.next(ui + 1, nxt);
        const char* nA = has_next ? (const char*)g.A + (size_t)nxt.pm * tstepA : cA; const char* nB = has_next ? (const char*)g.Bt + (size_t)nxt.pn * tstepB : cB;
        for (int t = 0; t < nt; t += 2) {
            const bool last = (t == nt - 2);
            const char* a1 = cA + (size_t)(t + 1) * kstep;
            const char* a2 = last ? nA : cA + (size_t)(t + 2) * kstep; const char* b2 = last ? nB : cB + (size_t)(t + 2) * kstep;
            const char* a3 = a2 + kstep; const char* b3 = b2 + kstep;
            PG8_LDB(B0, 0, 0); PG8_SCHED; PG8_LDA(At, 0, 0); PG8_STAGE(PG8_SA(1, 1), a1 + hstepA, voffA);
            PG8_WAIT_L(8); PG8_BAR; PG8_WAIT_L(0); PG8_MMA(0, 0, At, B0); PG8_BAR; PG8_SCHED;
            PG8_LDB(B1, 0, 1); PG8_STAGE(PG8_SB(0, 0), b2, voffB);
            PG8_BAR; PG8_WAIT_L(0); PG8_MMA(0, 1, At, B1); PG8_BAR;
            PG8_LDA(At, 0, 1); PG8_STAGE(PG8_SA(0, 0), a2, voffA);
            PG8_BAR; PG8_WAIT_L(0); PG8_MMA(1, 0, At, B0); PG8_BAR; PG8_SCHED;
            PG8_STAGE(PG8_SB(0, 1), b2 + hstepB, voffB);
            PG8_WAIT_V(6); PG8_BAR; PG8_MMA(1, 1, At, B1); PG8_BAR;
            PG8_LDB(B0, 1, 0); PG8_SCHED; PG8_LDA(At, 1, 0); PG8_STAGE(PG8_SA(0, 1), a2 + hstepA, voffA);
            PG8_WAIT_L(8); PG8_BAR; PG8_WAIT_L(0); PG8_MMA(0, 0, At, B0); PG8_BAR; PG8_SCHED;
            PG8_LDB(B1, 1, 1); PG8_STAGE(PG8_SB(1, 0), b3, voffB);
            PG8_BAR; PG8_WAIT_L(0); PG8_MMA(0, 1, At, B1); PG8_BAR;
            PG8_LDA(At, 1, 1); PG8_STAGE(PG8_SA(1, 0), a3, voffA);
            PG8_BAR; PG8_WAIT_L(0); PG8_MMA(1, 0, At, B0); PG8_BAR; PG8_SCHED;
            PG8_STAGE(PG8_SB(1, 1), b3 + hstepB, voffB);
            PG8_WAIT_V(6); PG8_BAR; PG8_MMA(1, 1, At, B1); PG8_BAR;
        }
        E(acc, cur, wr, wc, fr, fq);
        if (!has_next) break;
#pragma unroll
        for (int a = 0; a < 2; ++a)
#pragma unroll
            for (int b = 0; b < 2; ++b)
#pragma unroll
                for (int m = 0; m < 4; ++m)
#pragma unroll
                    for (int n = 0; n < 2; ++n) acc[a][b][m][n] = (f32x4){0.f, 0.f, 0.f, 0.f};
        cur = nxt; cA = nA; cB = nB; ++ui;
    }
    PG8_WAIT_V(0);
    if (wr == 0) PG8_BAR;
    PG8_BAR;
#undef PG8_SA
#undef PG8_SB
#undef PG8_STAGE
#undef PG8_LDA
#undef PG8_LDB
#undef PG8_MMA
#undef PG8_WAIT_V
#undef PG8_WAIT_L
#undef PG8_BAR
#undef PG8_SCHED
}
}

struct EpiStoreBf16 {
    static constexpr bool PERM = true;
    bf16_t* O; int ldc;
    __device__ __forceinline__ void operator()(const f32x4 (&acc)[2][2][4][2], const pg8::Unit& u, int wr_, int wc_, int fr_, int fq_) const {
        const int t2_ = otid(), wr = t2_ >> 8, wc = (t2_ >> 6) & 3, fr = t2_ & 15, fq = (t2_ >> 4) & 3; (void)wr_; (void)wc_; (void)fr_; (void)fq_;
        const int row0 = u.pm * 256 + wr * 64 + fr, col0 = u.pn * 256 + wc * 32 + 8 * fq;
#pragma unroll
        for (int ai = 0; ai < 2; ++ai)
#pragma unroll
            for (int m = 0; m < 4; ++m) { bf16_t* rowp = O + (size_t)(row0 + ai * 128 + m * 16) * ldc + col0;
#pragma unroll
                for (int bj = 0; bj < 2; ++bj) { const f32x4 v0 = acc[ai][bj][m][0], v1 = acc[ai][bj][m][1];
                    u32x4 w; w.x = cvt_pk_bf16(v0[0], v0[1]); w.y = cvt_pk_bf16(v0[2], v0[3]); w.z = cvt_pk_bf16(v1[0], v1[1]); w.w = cvt_pk_bf16(v1[2], v1[3]);
                    *(u32x4*)(rowp + bj * 128) = w; } }
    }
};
struct EpiGlu {
    static constexpr bool PERM = true;
    const bf16_t* Z; bf16_t* MIX; const float* bias;
    __device__ __forceinline__ void operator()(const f32x4 (&acc)[2][2][4][2], const pg8::Unit& u, int wr_, int wc_, int fr_, int fq_) const {
        const int t2_ = otid(), wr = t2_ >> 8, wc = (t2_ >> 6) & 3, fr = t2_ & 15, fq = (t2_ >> 4) & 3; (void)wr_; (void)wc_; (void)fr_; (void)fq_;
        const int row0 = u.pm * 256 + wr * 64 + fr, col0 = u.pn * 256 + wc * 32 + 8 * fq;
#pragma unroll
        for (int ai = 0; ai < 2; ++ai)
#pragma unroll
            for (int m = 0; m < 4; ++m) { const int row = row0 + ai * 128 + m * 16;
#pragma unroll
                for (int bj = 0; bj < 2; ++bj) { const int col = col0 + bj * 128;
                    const f32x4 b0 = *(const f32x4*)(bias + col), b1 = *(const f32x4*)(bias + col + 4);
                    const f32x4 v0 = acc[ai][bj][m][0] + b0, v1 = acc[ai][bj][m][1] + b1;
                    const u32x4 z = *(const u32x4*)(Z + (size_t)row * 512 + col);
                    u32x4 w;
                    w.x = cvt_pk_bf16(bflo(z.x) * sigmoidf_(v0[0]), bfhi(z.x) * sigmoidf_(v0[1]));
                    w.y = cvt_pk_bf16(bflo(z.y) * sigmoidf_(v0[2]), bfhi(z.y) * sigmoidf_(v0[3]));
                    w.z = cvt_pk_bf16(bflo(z.z) * sigmoidf_(v1[0]), bfhi(z.z) * sigmoidf_(v1[1]));
                    w.w = cvt_pk_bf16(bflo(z.w) * sigmoidf_(v1[2]), bfhi(z.w) * sigmoidf_(v1[3]));
                    *(u32x4*)(MIX + (size_t)row * 2048 + 1536 + col) = w; } }
    }
};
struct EpiResid {
    static constexpr bool PERM = false;
    const float* srcL; const float* srcC; float* dstL; float* dstC; const float* modsel;
    __device__ __forceinline__ void operator()(const f32x4 (&acc)[2][2][4][2], const pg8::Unit& u, int wr_, int wc_, int fr_, int fq_) const {
        const int t2_ = otid(), wr = t2_ >> 8, wc = (t2_ >> 6) & 3, fr = t2_ & 15, fq = (t2_ >> 4) & 3; (void)wr_; (void)wc_; (void)fr_; (void)fq_;
        const int rbase = u.pm * 256;
        const bool isc = rbase >= RL;
        const int mr = isc ? 4 : (rbase >> 12);
        const float* gate = modsel + (size_t)mr * 12288;
        const float* src = isc ? srcC - (size_t)RL * 2048 : srcL;
        float* dst = isc ? dstC - (size_t)RL * 2048 : dstL;
        const int row0 = rbase + wr * 64 + fr, col0 = u.pn * 256 + wc * 32 + 4 * fq;
#pragma unroll
        for (int ai = 0; ai < 2; ++ai)
#pragma unroll
            for (int m = 0; m < 4; ++m) { const size_t ro = (size_t)(row0 + ai * 128 + m * 16) * 2048;
#pragma unroll
                for (int bj = 0; bj < 2; ++bj)
#pragma unroll
                    for (int n = 0; n < 2; ++n) { const int col = col0 + bj * 128 + n * 16;
                        const f32x4 gg = *(const f32x4*)(gate + col), s = *(const f32x4*)(src + ro + col);
                        *(f32x4*)(dst + ro + col) = s + gg * acc[ai][bj][m][n]; } }
    }
};

struct EpiResidAtomic {
    static constexpr bool PERM = false;
    float* dstC; const float* gate;
    __device__ __forceinline__ void operator()(const f32x4 (&acc)[2][2][4][2], const pg8::Unit& u, int wr_, int wc_, int fr_, int fq_) const {
        const int t2_ = otid(), wr = t2_ >> 8, wc = (t2_ >> 6) & 3, fr = t2_ & 15, fq = (t2_ >> 4) & 3; (void)wr_; (void)wc_; (void)fr_; (void)fq_;
        float* dst = dstC - (size_t)RL * 2048;
        const int row0 = u.pm * 256 + wr * 64 + fr, col0 = u.pn * 256 + wc * 32 + 4 * fq;
#pragma unroll
        for (int ai = 0; ai < 2; ++ai)
#pragma unroll
            for (int m = 0; m < 4; ++m) { const size_t ro = (size_t)(row0 + ai * 128 + m * 16) * 2048;
#pragma unroll
                for (int bj = 0; bj < 2; ++bj)
#pragma unroll
                    for (int n = 0; n < 2; ++n) { const int col = col0 + bj * 128 + n * 16;
                        const f32x4 v = *(const f32x4*)(gate + col) * acc[ai][bj][m][n];
                        __hip_atomic_fetch_add(dst + ro + col, v[0], __ATOMIC_RELAXED, __HIP_MEMORY_SCOPE_AGENT); __hip_atomic_fetch_add(dst + ro + col + 1, v[1], __ATOMIC_RELAXED, __HIP_MEMORY_SCOPE_AGENT);
                        __hip_atomic_fetch_add(dst + ro + col + 2, v[2], __ATOMIC_RELAXED, __HIP_MEMORY_SCOPE_AGENT); __hip_atomic_fetch_add(dst + ro + col + 3, v[3], __ATOMIC_RELAXED, __HIP_MEMORY_SCOPE_AGENT); } }
    }
};

#define PHYS(i) ((i) + ((i) >> 4))
template <int R, bool INV>
__device__ __forceinline__ void fft_pass(LAS c2* buf, int logN, int s_lo, const LAS c2* twab, int ht) {
    const int N = 1 << logN, ngroups = N >> R, tshift = 13 - logN;
    constexpr int NE = 1 << R;
    constexpr float RH = 0.70710678118654752f;
#pragma unroll 2
    for (int q = ht; q < ngroups; q += 256) {
        const int qlo = q & (s_lo - 1), base = ((q - qlo) << R) + qlo;
        c2 x[NE];
#pragma unroll
        for (int k = 0; k < NE; ++k) x[k] = buf[PHYS(base + k * s_lo)];
#pragma unroll
        for (int u = 0; u < R; ++u) {
            const int h = INV ? (1 << u) : (1 << (R - 1 - u));
            const int e = (qlo * (N / (2 * h * s_lo))) << tshift;
            const c2 T = cmul(twab[e >> 6], twab[64 + (e & 63)]);
#pragma unroll
            for (int k = 0; k < NE; ++k) {
                if (k & h) continue;
                const int j8 = (k & (h - 1)) * (4 / h);
                const float cr = (j8 == 0) ? 1.f : (j8 == 1) ? RH : (j8 == 2) ? 0.f : -RH;
                const float ci = (j8 == 0) ? 0.f : (j8 == 1) ? -RH : (j8 == 2) ? -1.f : -RH;
                const c2 w = cmul(T, mkc2(cr, ci));
                if (!INV) { const c2 a = x[k], b = x[k + h]; x[k] = mkc2(a.x + b.x, a.y + b.y); x[k + h] = cmul(mkc2(a.x - b.x, a.y - b.y), w); }
                else { const c2 a = x[k], b = cmulc(x[k + h], w); x[k] = mkc2(a.x + b.x, a.y + b.y); x[k + h] = mkc2(a.x - b.x, a.y - b.y); }
            }
        }
#pragma unroll
        for (int k = 0; k < NE; ++k) buf[PHYS(base + k * s_lo)] = x[k];
    }
}
__device__ __forceinline__ void fft_fwd(LAS c2* buf, int logN, const LAS c2* tw, int ht) {
    __syncthreads();
    if (logN == 13) {
        fft_pass<3, false>(buf, 13, 1024, tw, ht); __syncthreads();
        fft_pass<3, false>(buf, 13, 128, tw, ht); __syncthreads();
        fft_pass<3, false>(buf, 13, 16, tw, ht); __syncthreads();
        fft_pass<3, false>(buf, 13, 2, tw, ht); __syncthreads();
        fft_pass<1, false>(buf, 13, 1, tw, ht); __syncthreads();
    } else {
        fft_pass<3, false>(buf, 9, 64, tw, ht); __syncthreads();
        fft_pass<3, false>(buf, 9, 8, tw, ht); __syncthreads();
        fft_pass<3, false>(buf, 9, 1, tw, ht); __syncthreads();
    }
}
__device__ __forceinline__ void fft_inv(LAS c2* buf, int logN, const LAS c2* tw, int ht) {
    __syncthreads();
    if (logN == 13) {
        fft_pass<1, true>(buf, 13, 1, tw, ht); __syncthreads();
        fft_pass<3, true>(buf, 13, 2, tw, ht); __syncthreads();
        fft_pass<3, true>(buf, 13, 16, tw, ht); __syncthreads();
        fft_pass<3, true>(buf, 13, 128, tw, ht); __syncthreads();
        fft_pass<3, true>(buf, 13, 1024, tw, ht); __syncthreads();
    } else {
        fft_pass<3, true>(buf, 9, 1, tw, ht); __syncthreads();
        fft_pass<3, true>(buf, 9, 8, tw, ht); __syncthreads();
        fft_pass<3, true>(buf, 9, 64, tw, ht); __syncthreads();
    }
}

__device__ __forceinline__ void fft_conv13(LAS c2* buf, const c2* __restrict__ KF, const LAS c2* tw, int ht) {
    __syncthreads();
    fft_pass<3, false>(buf, 13, 1024, tw, ht); __syncthreads();
    fft_pass<3, false>(buf, 13, 128, tw, ht); __syncthreads();
    fft_pass<3, false>(buf, 13, 16, tw, ht); __syncthreads();
    fft_pass<3, false>(buf, 13, 2, tw, ht); __syncthreads();
#pragma unroll 1
    for (int q = ht; q < 4096; q += 256) { const c2 x0 = buf[PHYS(2 * q)], x1 = buf[PHYS(2 * q + 1)]; const f32x4 kk = *(const f32x4*)(KF + 2 * q);
        const c2 a = cmul(mkc2(x0.x + x1.x, x0.y + x1.y), mkc2(kk[0], kk[1])), b = cmul(mkc2(x0.x - x1.x, x0.y - x1.y), mkc2(kk[2], kk[3]));
        buf[PHYS(2 * q)] = mkc2(a.x + b.x, a.y + b.y); buf[PHYS(2 * q + 1)] = mkc2(a.x - b.x, a.y - b.y); }
    __syncthreads();
    fft_pass<3, true>(buf, 13, 2, tw, ht); __syncthreads();
    fft_pass<3, true>(buf, 13, 16, tw, ht); __syncthreads();
    fft_pass<3, true>(buf, 13, 128, tw, ht); __syncthreads();
    fft_pass<3, true>(buf, 13, 1024, tw, ht); __syncthreads();
}

__device__ __forceinline__ void phase_p0(PRef p, unsigned char* shm) {
    const int tid = otid(), lane = tid & 63, wave = tid >> 6;
    float* mod = (float*)(p.ws + O_MOD); float* hid = (float*)(p.ws + O_HID);
    if (blockIdx.x == 0) for (int i = tid; i < 64 + 2048; i += 512) ((unsigned*)(p.ws + O_QCTR))[i] = 0u;
    { const float4* src = (const float4*)p.in[2]; float4* dst = (float4*)(p.ws + O_HCTX);
      for (int i = blockIdx.x * 512 + tid; i < RC * 2048 / 4; i += gridDim.x * 512) dst[i] = src[i]; }
    constexpr int N_MODIT = 768, N_HIDIT = 1088;
    float* sl = (float*)shm;
    float* part = sl + 5 * 2048;
    for (int it = blockIdx.x; it < N_MODIT + N_HIDIT; it += gridDim.x) {
        if (it < N_MODIT) {
            const int layer = it / 384, col0 = (it % 384) * 32;
#pragma unroll 10
            for (int i = tid; i < 5 * 2048; i += 512) { const int r = i >> 11, k = i & 2047; const float v = r < 4 ? p.in[1][r * 2048 + k] : p.in[3][k]; sl[i] = v * sigmoidf_(v); }
            __syncthreads();
            const int cl = tid & 31, kg = tid >> 5;
            const float* W = p.in[4] + ((size_t)layer * 2048 + kg * 128) * 12288 + col0 + cl;
            float a0 = 0.f, a1 = 0.f, a2 = 0.f, a3 = 0.f, a4 = 0.f;
#pragma unroll 16
            for (int k = 0; k < 128; ++k) { const float w = W[(size_t)k * 12288]; const int kk = kg * 128 + k;
                a0 += sl[kk] * w; a1 += sl[2048 + kk] * w; a2 += sl[4096 + kk] * w; a3 += sl[6144 + kk] * w; a4 += sl[8192 + kk] * w; }
            part[(kg * 5 + 0) * 32 + cl] = a0; part[(kg * 5 + 1) * 32 + cl] = a1; part[(kg * 5 + 2) * 32 + cl] = a2; part[(kg * 5 + 3) * 32 + cl] = a3; part[(kg * 5 + 4) * 32 + cl] = a4;
            __syncthreads();
            if (tid < 160) { const int r = tid >> 5, cc = tid & 31; float s = p.in[5][layer * 12288 + col0 + cc];
                for (int g = 0; g < 16; ++g) s += part[(g * 5 + r) * 32 + cc];
                mod[(size_t)(layer * 5 + r) * 12288 + col0 + cc] = s; }
            __syncthreads();
        } else {
            const int pi = (it - N_MODIT) * 8 + wave;
            const int layer = pi / 4352, q = pi % 4352;
            const int len = q < 4096 ? 4096 : 256, l = q < 4096 ? q : q - 4096;
            const float t = (float)l / (float)(len - 1);
            const float angb = (6.283185307179586f * (float)l) / (float)len;
            const float* w1 = p.in[10] + layer * 33 * 64; const float* w2 = p.in[12] + layer * 64 * 64;
            float pre = p.in[11][layer * 64 + lane] + t * w1[lane];
#pragma unroll 4
            for (int e = 0; e < 16; ++e) { const float band = 1e-4f + (float)e * ((15.f - 1e-4f) / 15.f); float s, c; sincosf(angb * band, &s, &c);
                pre += c * w1[(1 + e) * 64 + lane] - s * w1[(17 + e) * 64 + lane]; }
            const float h1 = sinf(p.in[15][(layer * 2 + 0) * 64 + lane] * pre);
            float* hb = (float*)shm + wave * 64;
            __syncthreads();
            hb[lane] = h1;
            __syncthreads();
            float pre2 = p.in[13][layer * 64 + lane];
#pragma unroll 16
            for (int i = 0; i < 64; ++i) pre2 += hb[i] * w2[i * 64 + lane];
            hid[(size_t)(layer * 4352 + q) * 64 + lane] = sinf(p.in[15][(layer * 2 + 1) * 64 + lane] * pre2);
            __syncthreads();
        }
    }
}

__device__ __forceinline__ void convT_tile(const float* __restrict__ W, int K, int N, bf16_t* __restrict__ WT, int tile, unsigned char* shm, int wave, int lane) {
    const int ntn = N / 64, k0 = (tile / ntn) * 64, n0 = (tile % ntn) * 64;
    float* T = (float*)shm + wave * (64 * 65);
    { const int r4 = lane >> 4, c4 = (lane & 15) * 4;
#pragma unroll
      for (int i = 0; i < 16; ++i) { const int rr = 4 * i + r4; const float4 v = *(const float4*)(W + (size_t)(k0 + rr) * N + n0 + c4);
          T[rr * 65 + c4] = v.x; T[rr * 65 + c4 + 1] = v.y; T[rr * 65 + c4 + 2] = v.z; T[rr * 65 + c4 + 3] = v.w; } }
    __builtin_amdgcn_fence(__ATOMIC_RELEASE, "wavefront"); __builtin_amdgcn_wave_barrier(); __builtin_amdgcn_fence(__ATOMIC_ACQUIRE, "wavefront");
    { const int n8 = lane >> 3, k8 = (lane & 7) * 8;
#pragma unroll
      for (int i = 0; i < 8; ++i) { const int n = 8 * i + n8; const float* sp = T + k8 * 65 + n;
          u32x4 o; o.x = cvt_pk_bf16(sp[0], sp[65]); o.y = cvt_pk_bf16(sp[2 * 65], sp[3 * 65]); o.z = cvt_pk_bf16(sp[4 * 65], sp[5 * 65]); o.w = cvt_pk_bf16(sp[6 * 65], sp[7 * 65]);
          *(u32x4*)(WT + (size_t)(n0 + n) * K + k0 + k8) = o; } }
    __builtin_amdgcn_fence(__ATOMIC_RELEASE, "wavefront"); __builtin_amdgcn_wave_barrier(); __builtin_amdgcn_fence(__ATOMIC_ACQUIRE, "wavefront");
}

__device__ __forceinline__ void s5prep_item(PRef p, int layer, int g, int part, unsigned char* shm) {
    const int tid = otid();
    c2* pw = (c2*)shm;
    c2* bbar = pw + 2 * 64 * 65;
    c2* cm = bbar + 2 * 64 * 16;
    c2* lamdt = cm + 2 * 16 * 64;
    if (tid < 128) { const int dir = tid >> 6, pp = tid & 63; const int o = ((layer * 2 + dir) * 32 + g) * 64 + pp;
        const float st = expf(p.in[20][(layer * 2 + dir) * 32 + g]);
        lamdt[tid] = mkc2(fminf(p.in[18][o], -1e-4f) * st, p.in[19][o] * st); }
    __syncthreads();
    for (int i = tid; i < 2 * 64 * 65; i += 512) { const int dp = i / 65, d = i % 65; const c2 z = lamdt[dp];
        float s, c; sincosf((float)d * z.y, &s, &c); const float m = expf((float)d * z.x); pw[i] = mkc2(m * c, m * s); }
    for (int i = tid; i < 2 * 64 * 16; i += 512) { const int dp = i >> 4, j = i & 15, dir = dp >> 6, pp = dp & 63;
        const int o = ((layer * 2 + dir) * 32 + g) * 64 + pp; const c2 z = lamdt[dp];
        const float st = expf(p.in[20][(layer * 2 + dir) * 32 + g]);
        const c2 lam = mkc2(fminf(p.in[18][o], -1e-4f), p.in[19][o]);
        float s, c; sincosf(z.y, &s, &c); const float sh = sinf(0.5f * z.y);
        const c2 em1 = mkc2(expm1f(z.x) * c - 2.f * sh * sh, expf(z.x) * s);
        const float den = 1.f / (lam.x * lam.x + lam.y * lam.y);
        const c2 coef = mkc2((em1.x * lam.x + em1.y * lam.y) * den, (em1.y * lam.x - em1.x * lam.y) * den);
        (void)st;
        const c2 bm = mkc2(p.in[21][(size_t)o * 16 + j], p.in[22][(size_t)o * 16 + j]);
        bbar[i] = cmul(coef, bm); }
    for (int i = tid; i < 2 * 16 * 64; i += 512) { const int dir = i >> 10, ii = (i >> 6) & 15, pp = i & 63;
        const size_t o = ((size_t)((layer * 2 + dir) * 32 + g) * 16 + ii) * 64 + pp; cm[i] = mkc2(p.in[23][o], p.in[24][o]); }
    __syncthreads();
    bf16_t* E = (bf16_t*)(p.ws + O_S5E); bf16_t* G = (bf16_t*)(p.ws + O_S5G); bf16_t* KT = (bf16_t*)(p.ws + O_S5K); c2* LT = (c2*)(p.ws + O_S5LT);
    if (part == 0 && tid < 128) { const int dir = tid >> 6, pp = tid & 63; LT[(dir * 32 + g) * 64 + pp] = pw[(dir * 64 + pp) * 65 + 64]; }
    for (int i = tid; i < 2 * 32 * 1024; i += 512) { const int dir = i >> 15, rr = (i >> 10) & 31, k = i & 1023; const int row = part * 32 + rr, pp = row >> 1, ri = row & 1, s = k >> 4, j = k & 15;
        const c2 w = cmul(pw[(dir * 64 + pp) * 65 + (dir == 0 ? 63 - s : s)], bbar[(dir * 64 + pp) * 16 + j]);
        E[((size_t)(dir * 32 + g) * 128 + row) * 1024 + k] = f2bf(ri ? w.y : w.x); }
    for (int i = tid; i < 2 * 256 * 128; i += 512) { const int dir = i >> 15, rr = (i >> 7) & 255, k = i & 127; const int t = part * 16 + (rr >> 4), ii = rr & 15, pp = k >> 1, ri = k & 1;
        const c2 w = cmul(cm[(dir * 16 + ii) * 64 + pp], pw[(dir * 64 + pp) * 65 + (dir == 0 ? t + 1 : 64 - t)]);
        G[((size_t)(dir * 32 + g) * 1024 + t * 16 + ii) * 128 + k] = f2bf(ri ? -w.y : w.x); }
    { const int pair = tid & 255, ii = pair >> 4, j = pair & 15, half = tid >> 8;
      const int dir = part < 2 ? 1 : 0;
      float* psum = (float*)(shm + 100352);
#pragma unroll 1
      for (int ph = 0; ph < 2; ++ph) {
          c2 cb[32];
#pragma unroll
          for (int q = 0; q < 32; ++q) { const int pp = ph * 32 + q; cb[q] = cmul(cm[(dir * 16 + ii) * 64 + pp], bbar[(dir * 64 + pp) * 16 + j]);
              if ((q & 7) == 7) asm volatile("" : "+v"(cb[q].x), "+v"(cb[q].y) :: "memory"); }
#pragma unroll 1
          for (int k = 0; k < 16; ++k) { const int dd = part * 32 + half * 16 + k;
              if (dd > 126) continue;
              const int d = dir ? 63 - dd : dd - 63;
              const c2* pwd = pw + (size_t)(dir * 64 + ph * 32) * 65 + d;
              float acc = ph ? psum[k * 512 + tid] : 0.f;
#pragma unroll
              for (int q = 0; q < 32; ++q) { const c2 w = pwd[q * 65]; acc += cb[q].x * w.x - cb[q].y * w.y;
                  if ((q & 7) == 7) asm volatile("" : "+v"(acc) :: "memory"); }
              if (ph == 0) { psum[k * 512 + tid] = acc; continue; }
              if (dd == 63) {
                  for (int pp = 0; pp < 64; ++pp) { const c2 w = cmul(cm[(0 * 16 + ii) * 64 + pp], bbar[(0 * 64 + pp) * 16 + j]); acc += w.x; } }
              KT[((size_t)g * 127 + dd) * 256 + ii * 16 + j] = f2bf(acc); } } }
    __syncthreads();
}

__device__ __forceinline__ void hyfilter_item(PRef p, int layer, bool isctx, int cg4, unsigned char* shm) {
    const int tid = otid(), hb = tid >> 8, ht = tid & 255, lane = tid & 63, wave = tid >> 6, c0 = cg4 * 4;
    const int L = isctx ? 256 : 4096, logN = isctx ? 9 : 13, N = 2 * L;
    const LAS c2* tw = (const LAS c2*)(shm + SCR_OFF + SCR_TW);
    const float* hid = (const float*)(p.ws + O_HID) + (size_t)(layer * 4352 + (isctx ? 4096 : 0)) * 64;
    c2* KF0b = isctx ? (c2*)(p.ws + O_KFC) + (size_t)c0 * 512 : (c2*)(p.ws + O_KF) + (size_t)c0 * 8192;
    c2* KF1b = isctx ? (c2*)(p.ws + O_KFC) + (size_t)(512 + c0) * 512 : (c2*)(p.ws + O_KF) + (size_t)(512 + c0) * 8192;
    float* red = (float*)shm;
    __syncthreads();
    const int fr = lane & 15, fq = lane >> 4;
    const int cdir = fr >> 3, co = (fr >> 2) & 1, ccc = fr & 3;
    bf16x8 bw[2];
    { const float* wp = p.in[14] + (size_t)layer * 64 * 2048 + cdir * 1024 + co * 512 + c0 + ccc;
#pragma unroll
      for (int kk = 0; kk < 2; ++kk) { float wv[8];
#pragma unroll
          for (int i = 0; i < 8; ++i) wv[i] = wp[(size_t)(kk * 32 + fq * 8 + i) * 2048];
          u32x4 w; w.x = cvt_pk_bf16(wv[0], wv[1]); w.y = cvt_pk_bf16(wv[2], wv[3]); w.z = cvt_pk_bf16(wv[4], wv[5]); w.w = cvt_pk_bf16(wv[6], wv[7]); bw[kk] = mk8(w); } }
    const float mind = -4.605170185988091f / 1.5f, maxd = -4.605170185988091f / 0.3f;
    const float adelta = fabsf(mind + (float)(c0 + ccc) * ((maxd - mind) / 511.f));
    float* ST = (float*)(KF0b + (size_t)ccc * N) + co;
    if (tid < 8) ((float*)(KF0b + (size_t)(tid & 3) * N))[2 * L + (tid >> 2)] = 0.f;
    float l1 = 0.f;
#pragma unroll 4
    for (int dt = wave; dt < L / 16; dt += 8) {
        const float* hr = hid + (size_t)(dt * 16 + fr) * 64 + fq * 8;
        f32x4 acc = (f32x4){0.f, 0.f, 0.f, 0.f};
#pragma unroll
        for (int kk = 0; kk < 2; ++kk) { const f32x4 x0 = *(const f32x4*)(hr + kk * 32), x1 = *(const f32x4*)(hr + kk * 32 + 4);
            u32x4 w; w.x = cvt_pk_bf16(x0[0], x0[1]); w.y = cvt_pk_bf16(x0[2], x0[3]); w.z = cvt_pk_bf16(x1[0], x1[1]); w.w = cvt_pk_bf16(x1[2], x1[3]);
            acc = __builtin_amdgcn_mfma_f32_16x16x32_bf16(mk8(w), bw[kk], acc, 0, 0, 0); }
#pragma unroll
        for (int r = 0; r < 4; ++r) { const int d = dt * 16 + fq * 4 + r; const float t = (float)d / (float)(L - 1);
            const float v = acc[r] * expf(-t * adelta);
            if (cdir == 0) { ST[2 * d] = v; l1 += fabsf(v); }
            else if (d >= 1) { ST[2 * (N - d)] = v; l1 += fabsf(v); } } }
    l1 += __shfl_xor(l1, 16); l1 += __shfl_xor(l1, 32);
    if (lane < 16) red[wave * 16 + lane] = l1;
    __threadfence();
    __syncthreads();
    __builtin_amdgcn_fence(__ATOMIC_ACQUIRE, "agent");
    LAS float* tot = (LAS float*)(shm + SCR_OFF);
    if (tid < 8) { float v = 0.f;
#pragma unroll
        for (int w = 0; w < 8; ++w) v += red[w * 16 + tid] + red[w * 16 + 8 + tid];
        tot[tid] = v; }
    __syncthreads();
    LAS c2* buf = (LAS c2*)shm + hb * FFT_PAD;
#pragma unroll 1
    for (int pr = 0; pr < 2; ++pr) { const int cc = 2 * pr + hb;
        const float inv0 = 0.5f / (tot[cc] * (float)N), inv1 = 0.5f / (tot[4 + cc] * (float)N);
        const c2* Z = KF0b + (size_t)cc * N;
#pragma unroll 8
        for (int i = ht; i < N; i += 256) buf[PHYS(i)] = Z[i];
        fft_fwd(buf, logN, tw, ht);
        c2* K0 = KF0b + (size_t)cc * N; c2* K1 = KF1b + (size_t)cc * N;
#pragma unroll 4
        for (int q = ht; q < N; q += 256) {
            const unsigned f = __brev((unsigned)q) >> (32 - logN);
            const unsigned q2 = __brev(((unsigned)N - f) & (unsigned)(N - 1)) >> (32 - logN);
            const c2 za = buf[PHYS(q)], zb = buf[PHYS((int)q2)];
            K0[q] = mkc2((za.x + zb.x) * inv0, (za.y - zb.y) * inv0);
            K1[q] = mkc2((za.y + zb.y) * inv1, (zb.x - za.x) * inv1); }
        __syncthreads(); }
}

__device__ __forceinline__ void xn_row(const float* hrow, const float* g, const float* shift, const float* scale, bf16_t* orow, int lane) {
    const float4* xr = (const float4*)hrow + lane;
    float4 v[8]; float s = 0.f;
#pragma unroll
    for (int j = 0; j < 8; ++j) { v[j] = xr[64 * j]; s += v[j].x * v[j].x + v[j].y * v[j].y + v[j].z * v[j].z + v[j].w * v[j].w; }
    const float r = rsqrtf(wave_sum(s) * (1.f / D) + 1e-6f);
    u32x2* o = (u32x2*)orow + lane;
#pragma unroll
    for (int j = 0; j < 8; ++j) { const float4 gg = ((const float4*)g)[lane + 64 * j], sh = ((const float4*)shift)[lane + 64 * j], sc = ((const float4*)scale)[lane + 64 * j];
        u32x2 w; w.x = cvt_pk_bf16(v[j].x * r * gg.x * (1.f + sc.x) + sh.x, v[j].y * r * gg.y * (1.f + sc.y) + sh.y);
        w.y = cvt_pk_bf16(v[j].z * r * gg.z * (1.f + sc.z) + sh.z, v[j].w * r * gg.w * (1.f + sc.w) + sh.w);
        o[64 * j] = w; }
}
__device__ __forceinline__ void xn_row1(PRef p, int layer, int which  , int row, int lane, const float* hL, const float* hC) {
    const float* mod = (const float*)(p.ws + O_MOD);
    const bool isc = row >= RL; const int mr = isc ? 4 : (row >> 12);
    const float* m = mod + (size_t)(layer * 5 + mr) * 12288 + (which ? 3 * 2048 : 0);
    const float* hrow = isc ? hC + (size_t)(row - RL) * 2048 : hL + (size_t)row * 2048;
    xn_row(hrow, p.in[which ? 29 : 6] + layer * 2048, m, m + 2048, (bf16_t*)(p.ws + O_XN) + (size_t)row * 2048, lane);
}

__device__ __forceinline__ void phase_lprep(PRef p, int layer, unsigned char* shm, const float* hL_, const float* hC_) {
    constexpr int N_S5 = 128, T_IN = 32 * 80, T_OUT = 32 * 32, T_UP = 32 * 176, T_DOWN = 88 * 32, T_GLU = 64;
    const int tid = otid(), wave = tid >> 6, lane = tid & 63, gw = blockIdx.x * 8 + wave, ngw = gridDim.x * 8;
    for (int rep = 0; rep < NREP(11); ++rep)
    for (int it = blockIdx.x; it < 384 + N_S5; it += gridDim.x) {
        int r = it;
        if (r >= 256 && r < 384) continue;
        if (r < 256) {
#if EN_HY
            const bool isctx = r >= 128; const int q = r & 127; if (!isctx || layer == 0) hyfilter_item(p, layer, isctx, q, shm);
#endif
            continue; }
        r -= 384;
#if EN_S5
        s5prep_item(p, layer, r >> 2, r & 3, shm);
#endif
    }
    __syncthreads();
    constexpr int NT = T_IN + T_OUT + T_UP + T_DOWN + T_GLU;
    for (int rep = 0; rep < NREP(12); ++rep)
    for (int it = gw; it < NT; it += ngw) {
        int r = it;
        if (r < T_IN) { convT_tile(p.in[7] + (size_t)layer * 2048 * 5120, 2048, 5120, (bf16_t*)(p.ws + O_WT_IN), r, shm, wave, lane); continue; } r -= T_IN;
        if (r < T_OUT) { convT_tile(p.in[28] + (size_t)layer * 2048 * 2048, 2048, 2048, (bf16_t*)(p.ws + O_WT_OUT), r, shm, wave, lane); continue; } r -= T_OUT;
        if (r < T_UP) { convT_tile(p.in[30] + (size_t)layer * 2048 * 11264, 2048, 11264, (bf16_t*)(p.ws + O_WT_UP), r, shm, wave, lane); continue; } r -= T_UP;
        if (r < T_DOWN) { convT_tile(p.in[33] + (size_t)layer * 5632 * 2048, 5632, 2048, (bf16_t*)(p.ws + O_WT_DOWN), r, shm, wave, lane); continue; } r -= T_DOWN;
        convT_tile(p.in[26] + (size_t)layer * 512 * 512, 512, 512, (bf16_t*)(p.ws + O_WT_GLU), r, shm, wave, lane);
    }
    for (int row = gw; row < RT; row += ngw) xn_row1(p, layer, 0, row, lane, hL_, hC_);
}

__device__ __forceinline__ void wave_sync_lds() { __builtin_amdgcn_fence(__ATOMIC_RELEASE, "wavefront"); __builtin_amdgcn_wave_barrier(); __builtin_amdgcn_fence(__ATOMIC_ACQUIRE, "wavefront"); }
__device__ __forceinline__ void hyT_witem(PRef p, int layer, bool isctx, int tile, unsigned char* shm, int wave, int lane) {
    const int L = isctx ? 256 : 4096, ntt = L / 32;
    const int b = tile / (ntt * 48), rem = tile % (ntt * 48), t0 = (rem / 48) * 32, c0 = (rem % 48) * 32;
    const bf16_t* A = (const bf16_t*)(p.ws + O_A) + (size_t)(isctx ? RL + b * 256 : b * 4096) * NIN;
    bf16_t* T = isctx ? (bf16_t*)(p.ws + O_HYTC) : (bf16_t*)(p.ws + O_HYT);
    float* X = (float*)shm + wave * (34 * 33);
#pragma unroll
    for (int i = 0; i < 3; ++i) { const int rr = 16 * i + (lane >> 2), c8 = (lane & 3) * 8, t = t0 - 1 + rr;
        if (rr < 34) { u32x4 v = (u32x4){0u, 0u, 0u, 0u};
            if (t >= 0 && t < L) v = *(const u32x4*)(A + (size_t)t * NIN + c0 + c8);
            float* d = X + rr * 33 + c8; d[0] = bflo(v.x); d[1] = bfhi(v.x); d[2] = bflo(v.y); d[3] = bfhi(v.y); d[4] = bflo(v.z); d[5] = bfhi(v.z); d[6] = bflo(v.w); d[7] = bfhi(v.w); } }
    wave_sync_lds();
    { const int cl = lane >> 1, t16 = (lane & 1) * 16, c = c0 + cl;
      const float w0 = p.in[8][(layer * 3 + 0) * 1536 + c], w1 = p.in[8][(layer * 3 + 1) * 1536 + c], w2 = p.in[8][(layer * 3 + 2) * 1536 + c], bb = p.in[9][layer * 1536 + c];
      float o[16];
#pragma unroll
      for (int j = 0; j < 16; ++j) { const int rr = t16 + j + 1; o[j] = w0 * X[(rr - 1) * 33 + cl] + w1 * X[rr * 33 + cl] + w2 * X[(rr + 1) * 33 + cl] + bb; }
      u32x4 wa, wb; wa.x = cvt_pk_bf16(o[0], o[1]); wa.y = cvt_pk_bf16(o[2], o[3]); wa.z = cvt_pk_bf16(o[4], o[5]); wa.w = cvt_pk_bf16(o[6], o[7]);
      wb.x = cvt_pk_bf16(o[8], o[9]); wb.y = cvt_pk_bf16(o[10], o[11]); wb.z = cvt_pk_bf16(o[12], o[13]); wb.w = cvt_pk_bf16(o[14], o[15]);
      bf16_t* dst = T + ((size_t)(b * 1536 + c)) * L + t0 + t16;
      *(u32x4*)dst = wa; *(u32x4*)(dst + 8) = wb; }
    wave_sync_lds();
}

constexpr int LDK = 136;
__device__ __forceinline__ void retkv_item(PRef p, int layer, int item, unsigned char* shm) {
    const int tid = otid(), lane = tid & 63, wave = tid >> 6, fr = lane & 15, fq = lane >> 4;
    int b, h, n, row0, cidx;
    if (item < 1024) { b = item >> 8; h = (item >> 5) & 7; n = item & 31; row0 = b * 4096 + n * 128; cidx = 2 + n; }
    else { const int q = item - 1024; b = q >> 4; h = (q >> 1) & 7; n = q & 1; row0 = RL + b * 256 + n * 128; cidx = n; }
    const float lgf = -expf(p.in[17][(layer * 2 + 0) * 8 + h]), lgb = -expf(p.in[17][(layer * 2 + 1) * 8 + h]);
    const bf16_t* A = (const bf16_t*)(p.ws + O_A);
    bf16_t* kTf = (bf16_t*)shm; bf16_t* kTb = kTf + 64 * LDK; bf16_t* vT = kTb + 64 * LDK;
#pragma unroll
    for (int i = 0; i < 2; ++i) { const int idx = tid + 512 * i, m = idx >> 3, d8 = (idx & 7) * 8;
        const u32x4 v = *(const u32x4*)(A + (size_t)(row0 + m) * NIN + C_K + h * 64 + d8);
        const float pf = 0.125f * expf((float)(127 - m) * lgf), pb = 0.125f * expf((float)m * lgb);
        const unsigned ww[4] = {v.x, v.y, v.z, v.w};
#pragma unroll
        for (int j = 0; j < 4; ++j) { const float lo = bflo(ww[j]), hi = bfhi(ww[j]);
            kTf[(d8 + 2 * j) * LDK + m] = f2bf(lo * pf); kTf[(d8 + 2 * j + 1) * LDK + m] = f2bf(hi * pf);
            kTb[(d8 + 2 * j) * LDK + m] = f2bf(lo * pb); kTb[(d8 + 2 * j + 1) * LDK + m] = f2bf(hi * pb); } }
#pragma unroll
    for (int i = 0; i < 4; ++i) { const int idx = tid + 512 * i, m = idx >> 4, e8 = (idx & 15) * 8;
        const u32x4 v = *(const u32x4*)(A + (size_t)(row0 + m) * NIN + C_V + h * 128 + e8);
        const unsigned ww[4] = {v.x, v.y, v.z, v.w};
#pragma unroll
        for (int j = 0; j < 4; ++j) { vT[(e8 + 2 * j) * LDK + m] = (bf16_t)(ww[j] & 0xffffu); vT[(e8 + 2 * j + 1) * LDK + m] = (bf16_t)(ww[j] >> 16); } }
    __syncthreads();
    const int dir = wave >> 2, mt = wave & 3;
    const bf16_t* kT = dir ? kTb : kTf;
    f32x4 acc[8];
#pragma unroll
    for (int nt = 0; nt < 8; ++nt) acc[nt] = (f32x4){0.f, 0.f, 0.f, 0.f};
#pragma unroll
    for (int kk = 0; kk < 4; ++kk) { const bf16x8 af = *(const bf16x8*)(kT + (16 * mt + fr) * LDK + kk * 32 + fq * 8);
#pragma unroll
        for (int nt = 0; nt < 8; ++nt) { const bf16x8 bf = *(const bf16x8*)(vT + (16 * nt + fr) * LDK + kk * 32 + fq * 8);
            acc[nt] = __builtin_amdgcn_mfma_f32_16x16x32_bf16(af, bf, acc[nt], 0, 0, 0); } }
    float* ST = (float*)(p.ws + O_RETST) + ((size_t)((b * 8 + h) * 2 + dir) * 34 + cidx) * 8192;
#pragma unroll
    for (int nt = 0; nt < 8; ++nt)
#pragma unroll
        for (int r = 0; r < 4; ++r) ST[(16 * mt + fq * 4 + r) * 128 + 16 * nt + fr] = acc[nt][r];
    __syncthreads();
}

__device__ __forceinline__ bf16x8 s5_ufrag(const bf16_t* A, int b, int g, int nt, int kk, int fr, int fq) {
    const int s = 2 * kk + (fq >> 1);
    const int row = (nt < 4) ? (b * 4096 + (16 * nt + fr) * 64 + s) : (RL + b * 256 + (fr & 3) * 64 + s);
    return *(const bf16x8*)(A + (size_t)row * NIN + C_U + g * 16 + (fq & 1) * 8);
}
constexpr int S5_UP = 2064;
__device__ __forceinline__ void s5_stage_u(const bf16_t* A, unsigned char* ul, int b, int g, int nt, int tid) {
#pragma unroll
    for (int i = 0; i < 4; ++i) { const int idx = tid + 512 * i, half = idx & 1, tok = (idx >> 1) & 63, ch = idx >> 7;
        const int row = (nt < 4) ? (b * 4096 + (16 * nt + ch) * 64 + tok) : (RL + b * 256 + (ch & 3) * 64 + tok);
        *(u32x4*)(ul + ch * S5_UP + tok * 32 + half * 16) = *(const u32x4*)(A + (size_t)row * NIN + C_U + g * 16 + half * 8); }
}
__device__ __forceinline__ void s5inc_item(PRef p, int item, unsigned char* shm) {
    const int tid = otid(), lane = tid & 63, wave = tid >> 6, fr = lane & 15, fq = lane >> 4;
    const int g = item >> 3, dir = (item >> 2) & 1, b = item & 3;
    const bf16_t* A = (const bf16_t*)(p.ws + O_A);
    const bf16_t* E = (const bf16_t*)(p.ws + O_S5E) + ((size_t)(dir * 32 + g) * 128 + 16 * wave + fr) * 1024 + fq * 8;
    bf16x8 af[32];
#pragma unroll
    for (int kk = 0; kk < 32; ++kk) af[kk] = *(const bf16x8*)(E + kk * 32);
    float* ST = (float*)(p.ws + O_S5ST) + (size_t)((g * 2 + dir) * 4 + b) * 68 * 128;
#pragma unroll 1
    for (int nt = 0; nt < 5; ++nt) {
        __syncthreads();
        s5_stage_u(A, shm, b, g, nt, tid);
        __syncthreads();
        f32x4 acc = (f32x4){0.f, 0.f, 0.f, 0.f};
#pragma unroll
        for (int kk = 0; kk < 32; ++kk) acc = __builtin_amdgcn_mfma_f32_16x16x32_bf16(af[kk], *(const bf16x8*)(shm + fr * S5_UP + kk * 64 + fq * 16), acc, 0, 0, 0);
        if (nt < 4 || fr < 4) { const int cidx = nt < 4 ? 4 + 16 * nt + fr : fr; *(f32x4*)(ST + (size_t)cidx * 128 + 16 * wave + fq * 4) = acc; }
    }
    __syncthreads();
}

__device__ __forceinline__ void phase_m1(PRef p, int layer, unsigned char* shm) {
    constexpr int N_RKV = 1088, N_S5I = 256;
    for (int it = blockIdx.x; it < N_S5I + N_RKV; it += gridDim.x) {
        int r = it;
        if (r < N_S5I) {
#if EN_S5
            for (int rep = 0; rep < NREP(8); ++rep) s5inc_item(p, r, shm);
#endif
            continue; }
        r -= N_S5I;
#if EN_RET
        for (int rep = 0; rep < NREP(9); ++rep) retkv_item(p, layer, r, shm);
#endif
    }
    __syncthreads();
#if EN_HY
    const int n_hyt = (layer == 0) ? 24576 + 1536 : 24576;
    const int tid = otid(), wave = tid >> 6, lane = tid & 63;
    for (int it = blockIdx.x * 8 + wave; it < n_hyt; it += gridDim.x * 8)
        for (int rep = 0; rep < NREP(10); ++rep) { if (it < 24576) hyT_witem(p, layer, false, it, shm, wave, lane); else hyT_witem(p, layer, true, it - 24576, shm, wave, lane); }
#endif
}

__device__ __forceinline__ void unpack8(u32x4 v, float (&o)[8]) { o[0] = bflo(v.x); o[1] = bfhi(v.x); o[2] = bflo(v.y); o[3] = bfhi(v.y); o[4] = bflo(v.z); o[5] = bfhi(v.z); o[6] = bflo(v.w); o[7] = bfhi(v.w); }
template <bool isctx>
__device__ __forceinline__ void hyconv_item(PRef p, int layer, int item, unsigned char* shm) {
    const int tid = otid(), hb = tid >> 8, ht = tid & 255;
    const int bp = item >> 8, c = 2 * (item & 255) + hb, b0 = 2 * bp, b1 = b0 + 1;
    const int L = isctx ? 256 : 4096, logN = isctx ? 9 : 13, N = 2 * L;
    LAS c2* buf = (LAS c2*)shm + hb * FFT_PAD;
    const LAS c2* tw = (const LAS c2*)(shm + SCR_OFF + SCR_TW);
    const bf16_t* T = isctx ? (const bf16_t*)(p.ws + O_HYTC) : (const bf16_t*)(p.ws + O_HYT);
    float* Y = isctx ? (float*)(p.ws + O_HYYC) : (float*)(p.ws + O_HYY);
    const c2* KF0 = isctx ? (const c2*)(p.ws + O_KFC) + (size_t)c * 512 : (const c2*)(p.ws + O_KF) + (size_t)c * 8192;
    const c2* KF1 = isctx ? (const c2*)(p.ws + O_KFC) + (size_t)(512 + c) * 512 : (const c2*)(p.ws + O_KF) + (size_t)(512 + c) * 8192;
    const bf16_t* v0 = T + (size_t)(b0 * 1536 + c) * L; const bf16_t* v1 = T + (size_t)(b1 * 1536 + c) * L;
    float* y0 = Y + (size_t)(b0 * 512 + c) * L; float* y1 = Y + (size_t)(b1 * 512 + c) * L;
    const float bias0 = p.in[16][(layer * 2 + 0) * 512 + c], bias1 = p.in[16][(layer * 2 + 1) * 512 + c];
    __syncthreads();
#pragma unroll 1
    for (int t8 = ht * 8; t8 < L; t8 += 2048) { float a[8], b[8]; unpack8(*(const u32x4*)(v0 + t8), a); unpack8(*(const u32x4*)(v1 + t8), b);
#pragma unroll
        for (int j = 0; j < 8; ++j) { buf[PHYS(t8 + j)] = mkc2(a[j], b[j]); buf[PHYS(t8 + j + L)] = mkc2(0.f, 0.f); } }
    if (!isctx) fft_conv13(buf, KF0, tw, ht);
    else { fft_fwd(buf, logN, tw, ht);
#pragma unroll 2
        for (int i = ht; i < N; i += 256) buf[PHYS(i)] = cmul(buf[PHYS(i)], KF0[i]);
        fft_inv(buf, logN, tw, ht); }
#pragma unroll 1
    for (int t8 = ht * 8; t8 < L; t8 += 2048) { float a[8], b[8], xa[8], xb[8];
        unpack8(*(const u32x4*)(v0 + t8), a); unpack8(*(const u32x4*)(v1 + t8), b);
        unpack8(*(const u32x4*)(v0 + (size_t)512 * L + t8), xa); unpack8(*(const u32x4*)(v1 + (size_t)512 * L + t8), xb);
        float za[8], zb[8];
#pragma unroll
        for (int j = 0; j < 8; ++j) { const c2 cv = buf[PHYS(t8 + j)]; za[j] = xa[j] * (cv.x + bias0 * a[j]); zb[j] = xb[j] * (cv.y + bias0 * b[j]);
            buf[PHYS(t8 + j)] = mkc2(za[j], zb[j]); buf[PHYS(t8 + j + L)] = mkc2(0.f, 0.f); }
        *(float4*)(y0 + t8) = make_float4(za[0], za[1], za[2], za[3]); *(float4*)(y0 + t8 + 4) = make_float4(za[4], za[5], za[6], za[7]);
        *(float4*)(y1 + t8) = make_float4(zb[0], zb[1], zb[2], zb[3]); *(float4*)(y1 + t8 + 4) = make_float4(zb[4], zb[5], zb[6], zb[7]); }
    if (!isctx) fft_conv13(buf, KF1, tw, ht);
    else { fft_fwd(buf, logN, tw, ht);
#pragma unroll 2
        for (int i = ht; i < N; i += 256) buf[PHYS(i)] = cmul(buf[PHYS(i)], KF1[i]);
        fft_inv(buf, logN, tw, ht); }
#pragma unroll 1
    for (int t8 = ht * 8; t8 < L; t8 += 2048) { float xa[8], xb[8];
        unpack8(*(const u32x4*)(v0 + (size_t)1024 * L + t8), xa); unpack8(*(const u32x4*)(v1 + (size_t)1024 * L + t8), xb);
        const float4 p0 = *(const float4*)(y0 + t8), p1 = *(const float4*)(y0 + t8 + 4), q0 = *(const float4*)(y1 + t8), q1 = *(const float4*)(y1 + t8 + 4);
        const float za[8] = {p0.x, p0.y, p0.z, p0.w, p1.x, p1.y, p1.z, p1.w}, zb[8] = {q0.x, q0.y, q0.z, q0.w, q1.x, q1.y, q1.z, q1.w};
        float oa[8], ob[8];
#pragma unroll
        for (int j = 0; j < 8; ++j) { const c2 cv = buf[PHYS(t8 + j)]; oa[j] = xa[j] * (cv.x + bias1 * za[j]); ob[j] = xb[j] * (cv.y + bias1 * zb[j]); }
        *(float4*)(y0 + t8) = make_float4(oa[0], oa[1], oa[2], oa[3]); *(float4*)(y0 + t8 + 4) = make_float4(oa[4], oa[5], oa[6], oa[7]);
        *(float4*)(y1 + t8) = make_float4(ob[0], ob[1], ob[2], ob[3]); *(float4*)(y1 + t8 + 4) = make_float4(ob[4], ob[5], ob[6], ob[7]); }
    __syncthreads();
}

__device__ __forceinline__ void phase_m2(PRef p, int layer, unsigned char* shm, bool scans) {
    const int gid = blockIdx.x * 512 + otid(), gsz = scans ? gridDim.x * 512 : 0x40000000;
#if EN_RET
    for (int ch = scans ? gid : 0x7fffffff - gsz; ch < 64 * 8192; ch += gsz) { const int bhd = ch >> 13, el = ch & 8191, dir = bhd & 1, h = (bhd >> 1) & 7;
        const float dec = expf(-128.f * expf(p.in[17][(layer * 2 + dir) * 8 + h]));
        float* base = (float*)(p.ws + O_RETST) + (size_t)bhd * 34 * 8192 + el;
        float inc[34];
#pragma unroll
        for (int sidx = 0; sidx < 34; ++sidx) { const int cidx = dir == 0 ? sidx : (sidx < 2 ? 1 - sidx : 35 - sidx); inc[sidx] = base[(size_t)cidx * 8192]; }
        float st = 0.f;
#pragma unroll
        for (int sidx = 0; sidx < 34; ++sidx) { const int cidx = dir == 0 ? sidx : (sidx < 2 ? 1 - sidx : 35 - sidx);
            base[(size_t)cidx * 8192] = st; st = dec * st + inc[sidx]; } }
#endif
#if EN_S5
    for (int ch = scans ? gid : 0x7fffffff - gsz; ch < 256 * 64; ch += gsz) { const int gdb = ch >> 6, pp = ch & 63, g = gdb >> 3, dir = (gdb >> 2) & 1;
        const c2 lt = ((const c2*)(p.ws + O_S5LT))[(dir * 32 + g) * 64 + pp];
        c2* base = (c2*)((float*)(p.ws + O_S5ST) + (size_t)gdb * 68 * 128) + pp;
        c2 st = mkc2(0.f, 0.f);
#pragma unroll 1
        for (int half = 0; half < 2; ++half) {
            c2 inc[34];
#pragma unroll
            for (int j = 0; j < 34; ++j) { const int sidx = half * 34 + j; const int cidx = dir == 0 ? sidx : (sidx < 4 ? 3 - sidx : 71 - sidx); inc[j] = base[(size_t)cidx * 64]; }
#pragma unroll
            for (int j = 0; j < 34; ++j) { const int sidx = half * 34 + j; const int cidx = dir == 0 ? sidx : (sidx < 4 ? 3 - sidx : 71 - sidx);
                base[(size_t)cidx * 64] = st; const c2 ns = cmul(lt, st); st = mkc2(ns.x + inc[j].x, ns.y + inc[j].y); } } }
#endif
#if EN_HY
    const int total = (layer == 0) ? 1024 : 512;
    for (int it = blockIdx.x; it < total; it += gridDim.x) { if (it < 512) hyconv_item<false>(p, layer, it, shm); else hyconv_item<true>(p, layer, it - 512, shm); }
#endif
}

__device__ __forceinline__ bf16x8 scale8(bf16x8 q, float s) {
    const u32x4 w = un8(q); u32x4 o;
    o.x = cvt_pk_bf16(bflo(w.x) * s, bfhi(w.x) * s); o.y = cvt_pk_bf16(bflo(w.y) * s, bfhi(w.y) * s);
    o.z = cvt_pk_bf16(bflo(w.z) * s, bfhi(w.z) * s); o.w = cvt_pk_bf16(bflo(w.w) * s, bfhi(w.w) * s);
    return mk8(o);
}
__device__ __forceinline__ void retout_item(PRef p, int layer, int item, unsigned char* shm) {
    const int tid = otid(), lane = tid & 63, wave = tid >> 6, fr = lane & 15, fq = lane >> 4;
    int b, h, n, row0, cidx;
    if (item < 1024) { b = item >> 8; h = (item >> 5) & 7; n = item & 31; row0 = b * 4096 + n * 128; cidx = 2 + n; }
    else { const int q = item - 1024; b = q >> 4; h = (q >> 1) & 7; n = q & 1; row0 = RL + b * 256 + n * 128; cidx = n; }
    const float lgf = -expf(p.in[17][(layer * 2 + 0) * 8 + h]), lgb = -expf(p.in[17][(layer * 2 + 1) * 8 + h]);
    const bf16_t* A = (const bf16_t*)(p.ws + O_A);
    bf16_t* MIX = (bf16_t*)(p.ws + O_XN);
    bf16_t* vT = (bf16_t*)shm;
    bf16_t* sTf = vT + 128 * LDK;
    bf16_t* sTb = sTf + 128 * 72;
    bf16_t* Pw = sTb + 128 * 72 + wave * 16 * LDK;
#pragma unroll
    for (int i = 0; i < 4; ++i) { const int idx = tid + 512 * i, m = idx >> 4, e8 = (idx & 15) * 8;
        const u32x4 v = *(const u32x4*)(A + (size_t)(row0 + m) * NIN + C_V + h * 128 + e8);
        const unsigned ww[4] = {v.x, v.y, v.z, v.w};
#pragma unroll
        for (int j = 0; j < 4; ++j) { vT[(e8 + 2 * j) * LDK + m] = (bf16_t)(ww[j] & 0xffffu); vT[(e8 + 2 * j + 1) * LDK + m] = (bf16_t)(ww[j] >> 16); } }
    { const float* SF = (const float*)(p.ws + O_RETST) + ((size_t)((b * 8 + h) * 2 + 0) * 34 + cidx) * 8192;
      const float* SB = (const float*)(p.ws + O_RETST) + ((size_t)((b * 8 + h) * 2 + 1) * 34 + cidx) * 8192;
#pragma unroll 4
      for (int i = 0; i < 16; ++i) { const int idx = tid + 512 * i, d = idx >> 7, e = idx & 127;
          sTf[e * 72 + d] = f2bf(SF[idx]); sTb[e * 72 + d] = f2bf(SB[idx]); } }
    __syncthreads();
    bf16x8 qa[2];
#pragma unroll
    for (int kk = 0; kk < 2; ++kk) qa[kk] = *(const bf16x8*)(A + (size_t)(row0 + 16 * wave + fr) * NIN + C_Q + h * 64 + kk * 32 + fq * 8);
#pragma unroll
    for (int nt = 0; nt < 8; ++nt) { f32x4 s = (f32x4){0.f, 0.f, 0.f, 0.f};
#pragma unroll
        for (int kk = 0; kk < 2; ++kk) { const bf16x8 kb = *(const bf16x8*)(A + (size_t)(row0 + 16 * nt + fr) * NIN + C_K + h * 64 + kk * 32 + fq * 8);
            s = __builtin_amdgcn_mfma_f32_16x16x32_bf16(qa[kk], kb, s, 0, 0, 0); }
        const int m = 16 * nt + fr;
#pragma unroll
        for (int r = 0; r < 4; ++r) { const int c = 16 * wave + fq * 4 + r; const float dd = (float)(c - m);
            const float dec = (m <= c) ? expf(dd * lgf) : expf(-dd * lgb);
            Pw[(fq * 4 + r) * LDK + m] = f2bf(s[r] * 0.125f * dec); } }
    __syncthreads();
    f32x4 acc[8];
#pragma unroll
    for (int et = 0; et < 8; ++et) acc[et] = (f32x4){0.f, 0.f, 0.f, 0.f};
#pragma unroll
    for (int kk = 0; kk < 4; ++kk) { const bf16x8 af = *(const bf16x8*)(Pw + fr * LDK + kk * 32 + fq * 8);
#pragma unroll
        for (int et = 0; et < 8; ++et) { const bf16x8 bf = *(const bf16x8*)(vT + (16 * et + fr) * LDK + kk * 32 + fq * 8);
            acc[et] = __builtin_amdgcn_mfma_f32_16x16x32_bf16(af, bf, acc[et], 0, 0, 0); } }
    { const int ca = 16 * wave + fr;
      const float sf = expf((float)(ca + 1) * lgf), sb = expf((float)(128 - ca) * lgb);
#pragma unroll
      for (int kk = 0; kk < 2; ++kk) { const bf16x8 af = scale8(qa[kk], sf), ab = scale8(qa[kk], sb);
#pragma unroll
          for (int et = 0; et < 8; ++et) { const bf16x8 b1 = *(const bf16x8*)(sTf + (16 * et + fr) * 72 + kk * 32 + fq * 8);
              acc[et] = __builtin_amdgcn_mfma_f32_16x16x32_bf16(af, b1, acc[et], 0, 0, 0);
              const bf16x8 b2 = *(const bf16x8*)(sTb + (16 * et + fr) * 72 + kk * 32 + fq * 8);
              acc[et] = __builtin_amdgcn_mfma_f32_16x16x32_bf16(ab, b2, acc[et], 0, 0, 0); } } }
#pragma unroll
    for (int r = 0; r < 4; ++r) { float ss = 0.f;
#pragma unroll
        for (int et = 0; et < 8; ++et) ss += acc[et][r] * acc[et][r];
        ss += __shfl_xor(ss, 1); ss += __shfl_xor(ss, 2); ss += __shfl_xor(ss, 4); ss += __shfl_xor(ss, 8);
        const float rinv = rsqrtf(ss * (1.f / 128.f) + 1e-6f);
        const size_t row = (size_t)(row0 + 16 * wave + fq * 4 + r);
#pragma unroll
        for (int et = 0; et < 8; ++et) { const int e = 16 * et + fr; const float gg = bf2f(A[row * NIN + C_G + h * 128 + e]);
            MIX[row * 2048 + 512 + h * 128 + e] = f2bf(acc[et][r] * rinv * gg * sigmoidf_(gg)); } }
    __syncthreads();
}

__device__ __forceinline__ void s5out_item(PRef p, int layer, int item, unsigned char* shm) {
    const int tid = otid(), lane = tid & 63, wave = tid >> 6, fr = lane & 15, fq = lane >> 4;
    const int g = item >> 3, b = (item >> 1) & 3, mh = item & 1;
    const bf16_t* A = (const bf16_t*)(p.ws + O_A);
    bf16_t* KT = (bf16_t*)shm;
    unsigned char* ul = shm + 65024;
    __syncthreads();
    { const u32x4* src = (const u32x4*)((const bf16_t*)(p.ws + O_S5K) + (size_t)g * 127 * 256); u32x4* dst = (u32x4*)shm;
      for (int i = tid; i < 127 * 256 / 8; i += 512) dst[i] = src[i]; }
    const int tb = 32 * mh + 4 * wave;
    bf16_t* Z = (bf16_t*)(p.ws + O_Z5);
    const f32x4 dv = *(const f32x4*)(p.in[25] + layer * 512 + g * 16 + fq * 4);
#pragma unroll 1
    for (int nt = 0; nt < 5; ++nt) {
        __syncthreads();
        s5_stage_u(A, ul, b, g, nt, tid);
        __syncthreads();
        f32x4 acc[4];
#pragma unroll
        for (int mi = 0; mi < 4; ++mi) acc[mi] = (f32x4){0.f, 0.f, 0.f, 0.f};
#pragma unroll 4
        for (int kk = 0; kk < 32; ++kk) {
            const bf16x8 bfr = *(const bf16x8*)(ul + fr * S5_UP + kk * 64 + fq * 16);
            const int sq = 2 * kk + (fq >> 1);
#pragma unroll
            for (int mi = 0; mi < 4; ++mi) { const bf16x8 af = *(const bf16x8*)(KT + (tb + mi - sq + 63) * 256 + fr * 16 + (fq & 1) * 8);
                acc[mi] = __builtin_amdgcn_mfma_f32_16x16x32_bf16(af, bfr, acc[mi], 0, 0, 0); } }
        const int cidx = nt < 4 ? 4 + 16 * nt + fr : (fr & 3);
#pragma unroll
        for (int dir = 0; dir < 2; ++dir) {
            const bf16_t* G = (const bf16_t*)(p.ws + O_S5G) + (size_t)(dir * 32 + g) * 1024 * 128;
            const float* ST = (const float*)(p.ws + O_S5ST) + (size_t)((g * 2 + dir) * 4 + b) * 68 * 128 + (size_t)cidx * 128;
#pragma unroll
            for (int kk = 0; kk < 4; ++kk) {
                const f32x4 x0 = *(const f32x4*)(ST + kk * 32 + fq * 8), x1 = *(const f32x4*)(ST + kk * 32 + fq * 8 + 4);
                u32x4 w; w.x = cvt_pk_bf16(x0[0], x0[1]); w.y = cvt_pk_bf16(x0[2], x0[3]); w.z = cvt_pk_bf16(x1[0], x1[1]); w.w = cvt_pk_bf16(x1[2], x1[3]);
                const bf16x8 bfr = mk8(w);
#pragma unroll
                for (int mi = 0; mi < 4; ++mi) { const bf16x8 af = *(const bf16x8*)(G + (size_t)((tb + mi) * 16 + fr) * 128 + kk * 32 + fq * 8);
                    acc[mi] = __builtin_amdgcn_mfma_f32_16x16x32_bf16(af, bfr, acc[mi], 0, 0, 0); } } }
        if (nt < 4 || fr < 4) {
#pragma unroll
            for (int mi = 0; mi < 4; ++mi) { const int t = tb + mi; const size_t row = nt < 4 ? (size_t)(b * 4096 + (16 * nt + fr) * 64 + t) : (size_t)(RL + b * 256 + fr * 64 + t);
                const u32x2 uu = *(const u32x2*)(ul + fr * S5_UP + t * 32 + fq * 8);
                const f32x4 y = acc[mi];
                u32x2 w; w.x = cvt_pk_bf16(gelu_tanh(y[0] + dv[0] * bflo(uu.x)), gelu_tanh(y[1] + dv[1] * bfhi(uu.x)));
                w.y = cvt_pk_bf16(gelu_tanh(y[2] + dv[2] * bflo(uu.y)), gelu_tanh(y[3] + dv[3] * bfhi(uu.y)));
                *(u32x2*)(Z + row * 512 + g * 16 + fq * 4) = w; } }
    }
    __syncthreads();
}

__device__ __forceinline__ void hyback_witem(PRef p, bool isctx, int tile, unsigned char* shm, int wave, int lane) {
    const int L = isctx ? 256 : 4096, ntt = L / 32;
    const int b = tile / (ntt * 16), rem = tile % (ntt * 16), t0 = (rem / 16) * 32, c0 = (rem % 16) * 32;
    const float* Y = isctx ? (const float*)(p.ws + O_HYYC) : (const float*)(p.ws + O_HYY);
    bf16_t* MIX = (bf16_t*)(p.ws + O_XN) + (size_t)(isctx ? RL + b * 256 : b * 4096) * 2048;
    float* T = (float*)shm + wave * (32 * 33);
    { const int cl = lane >> 1, t16 = (lane & 1) * 16; const float4* sp = (const float4*)(Y + (size_t)(b * 512 + c0 + cl) * L + t0 + t16);
      float* d = T + cl * 33 + t16;
#pragma unroll
      for (int q = 0; q < 4; ++q) { const float4 a = sp[q]; d[4 * q] = a.x; d[4 * q + 1] = a.y; d[4 * q + 2] = a.z; d[4 * q + 3] = a.w; } }
    wave_sync_lds();
    { const int tl = lane >> 1, c16 = (lane & 1) * 16; const float* sp = T + c16 * 33 + tl;
      u32x4 wa, wb;
      wa.x = cvt_pk_bf16(sp[0], sp[33]); wa.y = cvt_pk_bf16(sp[2 * 33], sp[3 * 33]); wa.z = cvt_pk_bf16(sp[4 * 33], sp[5 * 33]); wa.w = cvt_pk_bf16(sp[6 * 33], sp[7 * 33]);
      wb.x = cvt_pk_bf16(sp[8 * 33], sp[9 * 33]); wb.y = cvt_pk_bf16(sp[10 * 33], sp[11 * 33]); wb.z = cvt_pk_bf16(sp[12 * 33], sp[13 * 33]); wb.w = cvt_pk_bf16(sp[14 * 33], sp[15 * 33]);
      bf16_t* dst = MIX + (size_t)(t0 + tl) * 2048 + c0 + c16;
      *(u32x4*)dst = wa; *(u32x4*)(dst + 8) = wb; }
    wave_sync_lds();
}

__device__ __forceinline__ void zero_mix_cols(PRef p, int col0, int ncols) {
    bf16_t* MIX = (bf16_t*)(p.ws + O_XN);
    for (size_t i = (size_t)blockIdx.x * 512 + otid(); i < (size_t)RT * ncols; i += (size_t)gridDim.x * 512) MIX[(i / ncols) * 2048 + col0 + (i % ncols)] = 0;
}

__device__ __forceinline__ void phase_m3(PRef p, int layer, unsigned char* shm) {
    constexpr int N_S5O = 256, N_RO = 1088;
    for (int it = blockIdx.x; it < N_S5O + N_RO; it += gridDim.x) {
        int r = it;
        if (r < N_S5O) {
#if EN_S5
            for (int rep = 0; rep < NREP(8); ++rep) s5out_item(p, layer, r, shm);
#endif
            continue; }
        r -= N_S5O;
#if EN_RET
        for (int rep = 0; rep < NREP(9); ++rep) retout_item(p, layer, r, shm);
#endif
    }
    __syncthreads();
#if EN_HY
    const int n_hyb = (layer == 0) ? 8192 + 512 : 8192;
    const int tid = otid(), wave = tid >> 6, lane = tid & 63;
    for (int it = blockIdx.x * 8 + wave; it < n_hyb; it += gridDim.x * 8)
        for (int rep = 0; rep < NREP(10); ++rep) { if (it < 8192) hyback_witem(p, false, it, shm, wave, lane); else hyback_witem(p, true, it - 8192, shm, wave, lane); }
#else
    zero_mix_cols(p, 0, 512);
#endif
#if !EN_RET
    zero_mix_cols(p, 512, 1024);
#endif
#if !EN_S5
    zero_mix_cols(p, 1536, 512);
#endif
}

__device__ __forceinline__ void phase_conv(PRef p, int layer, int nseg) {
    const int tid = otid(), fg = tid & 63, xs = tid >> 6;
    bf16_t* GV = (bf16_t*)(p.ws + O_GV);
    const float* CW = p.in[31] + (size_t)layer * 9 * NFF; const float* CB = p.in[32] + (size_t)layer * NFF;
    for (int it = blockIdx.x; it < nseg * 11; it += gridDim.x) {
        const int seg = it / 11, f = (it % 11) * 512 + fg * 8;
        const bool isc = seg >= 256;
        float w[9][8], bias[8];
#pragma unroll
        for (int k = 0; k < 9; ++k) { const float4 a = *(const float4*)(CW + (size_t)k * NFF + f), bq = *(const float4*)(CW + (size_t)k * NFF + f + 4);
            w[k][0] = a.x; w[k][1] = a.y; w[k][2] = a.z; w[k][3] = a.w; w[k][4] = bq.x; w[k][5] = bq.y; w[k][6] = bq.z; w[k][7] = bq.w; }
        { const float4 a = *(const float4*)(CB + f), bq = *(const float4*)(CB + f + 4); bias[0] = a.x; bias[1] = a.y; bias[2] = a.z; bias[3] = a.w; bias[4] = bq.x; bias[5] = bq.y; bias[6] = bq.z; bias[7] = bq.w; }
        int W, x0; const bf16_t* lp[3]; bool lv[3];
        if (!isc) { const int b = seg >> 6, r = seg & 63; W = 64; x0 = 8 * xs;
#pragma unroll
            for (int ky = 0; ky < 3; ++ky) { const int yy = r + ky - 1; lv[ky] = (yy >= 0) && (yy < 64); lp[ky] = GV + ((size_t)b * 4096 + (size_t)(lv[ky] ? yy : r) * 64) * NUP + f; } }
        else { const int s2 = seg - 256, b = s2 >> 2, q = s2 & 3; W = 256; x0 = q * 64 + 8 * xs;
#pragma unroll
            for (int ky = 0; ky < 3; ++ky) { lv[ky] = (ky == 1); lp[ky] = GV + ((size_t)RL + b * 256) * NUP + f; } }
#pragma unroll 1
        for (int hx = 0; hx < 2; ++hx) { const int xb = x0 + 4 * hx;
            u32x4 gc[3][6], vv[4];
#pragma unroll
            for (int ky = 0; ky < 3; ++ky)
#pragma unroll
                for (int cx = 0; cx < 6; ++cx) { const int xx = xb - 1 + cx;
                    gc[ky][cx] = (lv[ky] && xx >= 0 && xx < W) ? *(const u32x4*)(lp[ky] + (size_t)xx * NUP) : (u32x4){0u, 0u, 0u, 0u}; }
#pragma unroll
            for (int xi = 0; xi < 4; ++xi) vv[xi] = *(const u32x4*)(lp[1] + (size_t)(xb + xi) * NUP + NFF);
#pragma unroll
            for (int xi = 0; xi < 4; ++xi) {
                float acc[8];
#pragma unroll
                for (int j = 0; j < 8; ++j) acc[j] = bias[j];
#pragma unroll
                for (int ky = 0; ky < 3; ++ky)
#pragma unroll
                    for (int kx = 0; kx < 3; ++kx) { const u32x4 gq = gc[ky][xi + kx]; const int k = ky * 3 + kx;
                        acc[0] += w[k][0] * bflo(gq.x); acc[1] += w[k][1] * bfhi(gq.x); acc[2] += w[k][2] * bflo(gq.y); acc[3] += w[k][3] * bfhi(gq.y);
                        acc[4] += w[k][4] * bflo(gq.z); acc[5] += w[k][5] * bfhi(gq.z); acc[6] += w[k][6] * bflo(gq.w); acc[7] += w[k][7] * bfhi(gq.w); }
                u32x4 o;
                o.x = cvt_pk_bf16(gelu_tanh(acc[0]) * bflo(vv[xi].x), gelu_tanh(acc[1]) * bfhi(vv[xi].x));
                o.y = cvt_pk_bf16(gelu_tanh(acc[2]) * bflo(vv[xi].y), gelu_tanh(acc[3]) * bfhi(vv[xi].y));
                o.z = cvt_pk_bf16(gelu_tanh(acc[4]) * bflo(vv[xi].z), gelu_tanh(acc[5]) * bfhi(vv[xi].z));
                o.w = cvt_pk_bf16(gelu_tanh(acc[6]) * bflo(vv[xi].w), gelu_tanh(acc[7]) * bfhi(vv[xi].w));
                *(u32x4*)((bf16_t*)lp[1] + (size_t)(xb + xi) * NUP + NFF) = o; } }
    }
}

__device__ __forceinline__ void final_norm_phase(const float* h, const float* g, float* out) {
    const int lane = otid() & 63, gw = blockIdx.x * 8 + (otid() >> 6), ngw = gridDim.x * 8;
    for (int row = gw; row < RL; row += ngw) {
        const float4* xr = (const float4*)(h + (size_t)row * D) + lane;
        float4 v[8]; float s = 0.f;
#pragma unroll
        for (int j = 0; j < 8; ++j) { v[j] = xr[64 * j]; s += v[j].x * v[j].x + v[j].y * v[j].y + v[j].z * v[j].z + v[j].w * v[j].w; }
        const float r = rsqrtf(wave_sum(s) * (1.f / D) + 1e-6f);
        float4* o = (float4*)(out + (size_t)row * D) + lane;
#pragma unroll
        for (int j = 0; j < 8; ++j) { const float4 gg = ((const float4*)g)[lane + 64 * j]; float4 w; w.x = v[j].x * r * gg.x; w.y = v[j].y * r * gg.y; w.z = v[j].z * r * gg.z; w.w = v[j].w * r * gg.w; o[64 * j] = w; }
    }
}

__device__ __forceinline__ void gbar(unsigned char* ws, unsigned k) {
    unsigned* base = (unsigned*)(ws + O_BAR);
    asm volatile("s_waitcnt vmcnt(0) lgkmcnt(0)" ::: "memory");
    __syncthreads();
    if (otid() == 0) {
        const unsigned g = blockIdx.x & 15u, ng = gridDim.x >> 4;
        __builtin_amdgcn_fence(__ATOMIC_RELEASE, "agent");
        const unsigned old = __hip_atomic_fetch_add(base + g * 32, 1u, __ATOMIC_RELAXED, __HIP_MEMORY_SCOPE_AGENT);
        if (old + 1u == k * ng) {
            const unsigned ot = __hip_atomic_fetch_add(base + 1024, 1u, __ATOMIC_RELAXED, __HIP_MEMORY_SCOPE_AGENT);
            if (ot + 1u == k * 16u) { for (unsigned gg = 0; gg < 16u; ++gg) __hip_atomic_store(base + 512 + gg * 32, k, __ATOMIC_RELAXED, __HIP_MEMORY_SCOPE_AGENT); }
        }
        while (__hip_atomic_load(base + 512 + g * 32, __ATOMIC_RELAXED, __HIP_MEMORY_SCOPE_AGENT) < k) __builtin_amdgcn_s_sleep(1);
        __builtin_amdgcn_fence(__ATOMIC_ACQUIRE, "agent");
    }
    __syncthreads();
}
__global__ void __launch_bounds__(512, 2) fwd_megakernel(Params p_) {
    extern __shared__ __attribute__((aligned(16))) unsigned char shm[];
    cg::grid_group grid = cg::this_grid();
    LAS unsigned char* lds = (LAS unsigned char*)shm;
#define mod ((const float*)(getp().ws + O_MOD))
#define hctx ((float*)(getp().ws + O_HCTX))
#define XN ((bf16_t*)(getp().ws + O_XN))
#define Abuf ((bf16_t*)(getp().ws + O_A))
#define GV ((bf16_t*)(getp().ws + O_GV))
    pg8::StaticOrder S;
    unsigned bar_n = 0;
#define GBAR() do { bar_n += 1u; gbar(getp().ws, bar_n); } while (0)
    { const int tid = otid();
      if (tid < 128) { const int e = tid < 64 ? tid << 6 : tid - 64; float sn, cs; sincospif((float)e * (1.f / 4096.f), &sn, &cs); ((LAS c2*)(shm + SCR_OFF + SCR_TW))[tid] = mkc2(cs, -sn); }
      __syncthreads(); }

    for (int rep = 0; rep < NREP(0); ++rep) { phase_p0(getp(), shm); grid.sync(); }
    for (int rep = 0; rep < ((REP_MASK >> 13) & 1) * 24; ++rep) GBAR();
#pragma unroll 2
    for (int layer = 0; layer < 2; ++layer) {
        const bool last = layer == 1;
#define hL (layer == 0 ? getp().in[0] : (const float*)getp().out)
#define hC (layer == 0 ? getp().in[2] : (const float*)hctx)
        const int Mrest = last ? RL : RT;
        for (int rep = 0; rep < NREP(1); ++rep) { phase_lprep(getp(), layer, shm, hL, hC); GBAR(); }
        { pg8::Gemm g{XN, (const bf16_t*)(getp().ws + O_WT_IN), RT, NIN, 2048, 2048, 2048}; S.init(g.M, g.N, gridDim.x, blockIdx.x);
          EpiStoreBf16 E{Abuf, NIN}; GEMM_REP(pg8::gemm_phase(lds, g, S, E); GBAR();) }
        for (int rep = 0; rep < NREP(3); ++rep) { phase_m1(getp(), layer, shm); GBAR(); }
        phase_m2(getp(), layer, shm, true);
        GBAR();
        for (int rep = 1; rep < NREP(4); ++rep) { phase_m2(getp(), layer, shm, false); GBAR(); }
        for (int rep = 0; rep < NREP(5); ++rep) { phase_m3(getp(), layer, shm); GBAR(); }
        { pg8::Gemm g{(const bf16_t*)(getp().ws + O_Z5), (const bf16_t*)(getp().ws + O_WT_GLU), RT, 512, 512, 512, 512}; S.init(g.M, g.N, gridDim.x, blockIdx.x);
          EpiGlu E{(const bf16_t*)(getp().ws + O_Z5), XN, getp().in[27] + layer * 512};
          GEMM_REP(pg8::gemm_phase(lds, g, S, E); GBAR();)
        }
        { pg8::Gemm g{XN, (const bf16_t*)(getp().ws + O_WT_OUT), RL, 2048, 2048, 2048, 2048}; S.init(g.M, g.N, gridDim.x, blockIdx.x);
          EpiResid E{hL, hC, getp().out, hctx, mod + (size_t)layer * 5 * 12288 + 2 * 2048}; pg8::gemm_phase(lds, g, S, E); }
        if (layer == 0) {
            for (int L2 = blockIdx.x; L2 < 256; L2 += gridDim.x) { const int part = L2 & 7, uu = L2 >> 3; pg8::SingleOrder S1{RL / 256 + (uu & 3), uu >> 2, true};
            pg8::Gemm g{XN + part * 256, (const bf16_t*)(getp().ws + O_WT_OUT) + part * 256, RT, 2048, 256, 2048, 2048};
            EpiResidAtomic E{hctx, mod + (size_t)(layer * 5 + 4) * 12288 + 2 * 2048}; pg8::gemm_phase(lds, g, S1, E); }
        }
        GBAR();
        { const int tid = otid(); for (int row = blockIdx.x * 8 + (tid >> 6); row < Mrest; row += gridDim.x * 8) xn_row1(getp(), layer, 1, row, tid & 63, getp().out, hctx); }
        GBAR();
        for (int rep = 1; rep < NREP(6); ++rep) { const int tid = otid(); for (int row = blockIdx.x * 8 + (tid >> 6); row < Mrest; row += gridDim.x * 8) xn_row1(getp(), layer, 1, row, tid & 63, getp().out, hctx); GBAR(); }
        { pg8::Gemm g{XN, (const bf16_t*)(getp().ws + O_WT_UP), Mrest, NUP, 2048, 2048, 2048}; S.init(g.M, g.N, gridDim.x, blockIdx.x);
          EpiStoreBf16 E{GV, NUP};
          pg8::gemm_phase(lds, g, S, E);
          GBAR(); }
        phase_conv(getp(), layer, last ? 256 : 272);
        GBAR();
        { pg8::Gemm g{GV + NFF, (const bf16_t*)(getp().ws + O_WT_DOWN), RL, 2048, NFF, NUP, NFF}; S.init(g.M, g.N, gridDim.x, blockIdx.x);
          EpiResid E{getp().out, hctx, getp().out, hctx, mod + (size_t)layer * 5 * 12288 + 5 * 2048}; pg8::gemm_phase(lds, g, S, E); }
        if (layer == 0) {
            for (int L2 = blockIdx.x; L2 < 128; L2 += gridDim.x) { const int part = L2 & 3, uu = L2 >> 2; pg8::SingleOrder S1{RL / 256 + (uu & 3), (uu >> 2) & 7, true};
            pg8::Gemm g{GV + NFF + part * 1408, (const bf16_t*)(getp().ws + O_WT_DOWN) + part * 1408, RT, 2048, 1408, NUP, NFF};
            EpiResidAtomic E{hctx, mod + (size_t)(layer * 5 + 4) * 12288 + 5 * 2048}; pg8::gemm_phase(lds, g, S1, E); }
        }
        GBAR();
    }
    final_norm_phase(getp().out, getp().in[34], getp().out);
}

extern "C" void kernel_launch(void* const* d_in, const int* in_sizes, int n_in, void* d_out, int out_size, void* d_ws, size_t ws_size, hipStream_t stream) {
    static int grid_blocks = 0;
    if (grid_blocks == 0) {
        int dev = 0, cus = 0, per_cu = 0;
        (void)hipGetDevice(&dev);
        (void)hipDeviceGetAttribute(&cus, hipDeviceAttributeMultiprocessorCount, dev);
        if (hipFuncSetAttribute((const void*)fwd_megakernel, hipFuncAttributeMaxDynamicSharedMemorySize, LDS_BYTES) != hipSuccess) fprintf(stderr, "hipFuncSetAttribute failed\n");
        (void)hipOccupancyMaxActiveBlocksPerMultiprocessor(&per_cu, (const void*)fwd_megakernel, 512, LDS_BYTES);
        (void)hipGetLastError();
        grid_blocks = cus & ~15;
        if (n_in != 35 || ws_size < O_END2) { fprintf(stderr, "kernel_launch: unexpected n_in %d or workspace %zu < %zu\n", n_in, ws_size, (size_t)O_END2); grid_blocks = -1; }
    }
    if (grid_blocks < 0) return;
    Params p{};
    for (int i = 0; i < 35; ++i) p.in[i] = (const float*)d_in[i];
    p.out = (float*)d_out; p.ws = (unsigned char*)d_ws; p.ws_size = (unsigned long long)ws_size;
    void* args[] = {&p};
    hipError_t e = hipLaunchCooperativeKernel((const void*)fwd_megakernel, dim3(grid_blocks), dim3(512), args, LDS_BYTES, stream);
    if (e != hipSuccess) fprintf(stderr, "cooperative launch failed: %s (grid %d)\n", hipGetErrorString(e), grid_blocks);
}
```

```cpp
#include <hip/hip_runtime.h>
#include <hip/hip_cooperative_groups.h>
#include <cstdio>
namespace cg = cooperative_groups;

#define LAS __attribute__((address_space(3)))
typedef unsigned short bf16_t;
typedef short bf16x8 __attribute__((ext_vector_type(8)));
typedef float f32x4 __attribute__((ext_vector_type(4)));
typedef unsigned u32x4 __attribute__((ext_vector_type(4)));
typedef unsigned u32x2 __attribute__((ext_vector_type(2)));
typedef float c2 __attribute__((ext_vector_type(2)));

#ifndef REP_MASK
#define REP_MASK 0
#endif
#define NREP(bit) ((REP_MASK >> (bit)) & 1 ? 2 : 1)
#if (REP_MASK >> 2) & 1
#define GEMM_REP(stmt) stmt stmt
#else
#define GEMM_REP(stmt) stmt
#endif
#ifndef EN_RET
#define EN_RET 1
#endif
#ifndef EN_S5
#define EN_S5 1
#endif
#ifndef EN_HY
#define EN_HY 1
#endif

struct Params {
    const float* in[35];
    float* out;
    unsigned char* ws;
    unsigned long long ws_size;
};

typedef const __attribute__((address_space(4))) Params& PRef;
__device__ __forceinline__ PRef getp() { const __attribute__((address_space(4))) Params* kp = (const __attribute__((address_space(4))) Params*)__builtin_amdgcn_kernarg_segment_ptr(); asm volatile("" : "+s"(kp)); return *kp; }
constexpr int D = 2048, NB = 4, SEQ = 4096, LC = 256, RL = NB * SEQ, RC = NB * LC, RT = RL + RC;
constexpr int NIN = 5120, NFF = 5632, NUP = 11264;
constexpr int C_Q = 1536, C_K = 2048, C_V = 2560, C_G = 3584, C_U = 4608;
constexpr int LDS_BYTES = 143360, SCR_OFF = 139264, SCR_WCOL = 64, SCR_TW = 1088, FFT_PAD = 8704;

constexpr size_t al256(size_t x) { return (x + 255) & ~(size_t)255; }
constexpr size_t O_WT_IN = 0;
constexpr size_t O_WT_OUT = O_WT_IN + (size_t)5120 * 2048 * 2;
constexpr size_t O_WT_UP = O_WT_OUT + (size_t)2048 * 2048 * 2;
constexpr size_t O_WT_DOWN = O_WT_UP + (size_t)11264 * 2048 * 2;
constexpr size_t O_WT_GLU = O_WT_DOWN + (size_t)2048 * 5632 * 2;
constexpr size_t O_HCTX = O_WT_GLU + (size_t)512 * 512 * 2;
constexpr size_t O_MOD = O_HCTX + (size_t)RC * 2048 * 4;
constexpr size_t O_HID = O_MOD + al256((size_t)2 * 5 * 12288 * 4);
constexpr size_t O_TW = O_HID + (size_t)2 * 4352 * 64 * 4;
constexpr size_t O_KF = O_TW + 4096 * 8;
constexpr size_t O_KFC = O_KF + (size_t)2 * 512 * 8192 * 8;
constexpr size_t O_S5E = O_KFC + (size_t)2 * 512 * 512 * 8;
constexpr size_t O_S5G = O_S5E + (size_t)64 * 128 * 1024 * 2;
constexpr size_t O_S5K = O_S5G + (size_t)64 * 1024 * 128 * 2;
constexpr size_t O_S5LT = O_S5K + al256((size_t)32 * 127 * 256 * 2);
constexpr size_t O_XN = O_S5LT + 64 * 64 * 8;
constexpr size_t O_U = O_XN + (size_t)RT * 2048 * 2;
constexpr size_t O_A = O_U;
constexpr size_t O_HYT = O_A + (size_t)RT * 5120 * 2;
constexpr size_t O_HYTC = O_HYT + (size_t)4 * 1536 * 4096 * 2;
constexpr size_t O_HYY = O_HYTC + (size_t)4 * 1536 * 256 * 2;
constexpr size_t O_HYYC = O_HYY + (size_t)4 * 512 * 4096 * 4;
constexpr size_t O_Z5 = O_HYYC + (size_t)4 * 512 * 256 * 4;
constexpr size_t O_RETST = O_Z5 + (size_t)RT * 512 * 2;
constexpr size_t O_S5ST = O_RETST + (size_t)64 * 34 * 8192 * 4;
constexpr size_t O_MIXEND = O_S5ST + (size_t)256 * 68 * 128 * 4;
constexpr size_t O_GV = O_U;
constexpr size_t O_END = O_GV + (size_t)RT * 11264 * 2;
static_assert(O_MIXEND <= O_END, "mixer buffers must fit in the union region");
constexpr size_t O_QCTR = O_END;
constexpr size_t O_BAR = O_QCTR + 256;
constexpr size_t O_END2 = O_BAR + 8192;

__device__ __forceinline__ int otid() { int t = (int)__builtin_amdgcn_workitem_id_x(); asm volatile("" : "+v"(t)); return t; }
__device__ __forceinline__ unsigned cvt_pk_bf16(float lo, float hi) { unsigned r; asm("v_cvt_pk_bf16_f32 %0, %1, %2" : "=v"(r) : "v"(lo), "v"(hi)); return r; }
__device__ __forceinline__ float bf2f(unsigned short b) { return __uint_as_float(((unsigned)b) << 16); }
__device__ __forceinline__ float bflo(unsigned w) { return __uint_as_float(w << 16); }
__device__ __forceinline__ float bfhi(unsigned w) { return __uint_as_float(w & 0xffff0000u); }
__device__ __forceinline__ unsigned short f2bf(float f) { return (unsigned short)(cvt_pk_bf16(f, 0.f) & 0xffffu); }
__device__ __forceinline__ float sigmoidf_(float x) { return 1.f / (1.f + __expf(-x)); }
__device__ __forceinline__ float gelu_tanh(float x) { const float u = 0.7978845608028654f * (x + 0.044715f * x * x * x); return x / (1.f + __expf(-2.f * u)); }
__device__ __forceinline__ float wave_sum(float v) {
#pragma unroll
    for (int o = 1; o < 64; o <<= 1) v += __shfl_xor(v, o);
    return v;
}
__device__ __forceinline__ c2 mkc2(float x, float y) { c2 r; r.x = x; r.y = y; return r; }
__device__ __forceinline__ c2 cmul(c2 a, c2 b) { return mkc2(a.x * b.x - a.y * b.y, a.x * b.y + a.y * b.x); }
__device__ __forceinline__ c2 cmulc(c2 a, c2 b) { return mkc2(a.x * b.x + a.y * b.y, a.y * b.x - a.x * b.y); }
__device__ __forceinline__ bf16x8 mk8(u32x4 w) { union { u32x4 u; bf16x8 b; } x; x.u = w; return x.b; }
__device__ __forceinline__ u32x4 un8(bf16x8 b) { union { u32x4 u; bf16x8 b; } x; x.b = b; return x.u; }

namespace pg8 {
constexpr int BM = 256, BK = 64, HALF = 128, HTB = HALF * BK * 2, STAGE_BYTES = 8 * HTB, NXCD = 8, WGM = 8;
__host__ __device__ __forceinline__ int lds_byte(int r, int c) { const int st = (r >> 4) * 2 + (c >> 5), rr = r & 15, cc = c & 31, ob = rr * 64 + cc * 2; return st * 1024 + (ob ^ (((ob >> 9) & 1) << 5)); }
__host__ __device__ __forceinline__ void stage_rc(int b, int& R, int& C) { const int st = b / 1024, sb = b % 1024, swz = sb ^ (((sb >> 9) & 1) << 5); R = (st >> 1) * 16 + swz / 64; C = (st & 1) * 32 + (swz % 64) / 2; }
__host__ __device__ __forceinline__ int perm32(int rho) { const int n = rho >> 4, i = rho & 15; return 8 * (i >> 2) + 4 * n + (i & 3); }
struct Unit { int pm, pn; };
struct Gemm { const bf16_t* A; const bf16_t* Bt; int M, N, K, lda, ldb; };
struct StaticOrder {
    int nM, nN, nwg, G, c;
    __device__ void init(int M, int N, int G_, int c_) { nM = M / BM; nN = N / BM; nwg = nM * nN; G = G_; c = c_; }
    __device__ bool next(int i, Unit& u) const {
        const long L = (long)i * G + c; if (L >= nwg) return false;
        int wgid = (int)L; { const int q = nwg / NXCD, r = nwg % NXCD, xcd = wgid % NXCD, off = wgid / NXCD; wgid = (xcd < r ? xcd * (q + 1) : r * (q + 1) + (xcd - r) * q) + off; }
        const int nig = WGM * nN, gid = wgid / nig, fm = gid * WGM, gsz = (nM - fm) < WGM ? (nM - fm) : WGM;
        u.pm = fm + ((wgid % nig) % gsz); u.pn = (wgid % nig) / gsz; return true;
    }
};

struct SingleOrder { int pm, pn; bool has; __device__ __forceinline__ bool next(int i, Unit& u) const { u.pm = pm; u.pn = pn; return has && i == 0; } };
template <class Epi, class Sched>
__device__ __forceinline__ void gemm_phase(LAS unsigned char* lds, const Gemm g, const Sched& S, const Epi& E) {
    const int tid = otid(), wid = __builtin_amdgcn_readfirstlane(tid >> 6), lane = tid & 63, wr = wid >> 2, wc = wid & 3, fr = lane & 15, fq = lane >> 4;
    const int K = g.K, nt = K / BK, lda = g.lda, ldb = g.ldb;
    unsigned voffA, voffB;
    { int R, C; stage_rc(tid * 16, R, C); const int Rb = Epi::PERM ? ((R & ~31) + perm32(R & 31)) : R;
      voffA = (unsigned)(R * lda + C) * 2u; voffB = (unsigned)(Rb * ldb + C) * 2u; }
    const size_t r64voffA = (size_t)64 * lda * 2, r64voffB = (size_t)64 * ldb * 2;
    const size_t kstep = (size_t)(BK * 2);
    const size_t hstepA = (size_t)HALF * lda * 2, hstepB = (size_t)HALF * ldb * 2;
    const size_t tstepA = 2 * hstepA, tstepB = 2 * hstepB;
    const unsigned ldsw = (unsigned)wid * 1024u;
    const int aoff = lds_byte(wr * 64 + fr, fq * 8), boff = lds_byte(wc * 32 + fr, fq * 8);
#define PG8_SA(b, h) (((b) * 2 + (h)) * HTB)
#define PG8_SB(b, h) ((4 + (b) * 2 + (h)) * HTB)
#define PG8_STAGE(bufoff, gbase, voff) do { _Pragma("unroll") for (int _i = 0; _i < 2; ++_i) \
        __builtin_amdgcn_global_load_lds((const unsigned*)((const char*)(gbase) + (size_t)_i * r64##voff + (voff)), (LAS unsigned*)(lds + (bufoff) + ldsw + _i * 8192), 16, 0, 0); } while (0)
#define PG8_LDA(dst, b, h) do { _Pragma("unroll") for (int m = 0; m < 4; ++m) _Pragma("unroll") for (int k = 0; k < 2; ++k) dst[m][k] = *(const LAS bf16x8*)(lds + PG8_SA(b, h) + aoff + m * 2048 + k * 1024); } while (0)
#define PG8_LDB(dst, b, h) do { _Pragma("unroll") for (int n = 0; n < 2; ++n) _Pragma("unroll") for (int k = 0; k < 2; ++k) dst[n][k] = *(const LAS bf16x8*)(lds + PG8_SB(b, h) + boff + n * 2048 + k * 1024); } while (0)
#define PG8_MMA(ai, bj, At, Bt) do { __builtin_amdgcn_s_setprio(1); _Pragma("unroll") for (int m = 0; m < 4; ++m) _Pragma("unroll") for (int n = 0; n < 2; ++n) _Pragma("unroll") for (int k = 0; k < 2; ++k) \
        acc[ai][bj][m][n] = __builtin_amdgcn_mfma_f32_16x16x32_bf16(Bt[n][k], At[m][k], acc[ai][bj][m][n], 0, 0, 0); __builtin_amdgcn_s_setprio(0); } while (0)
#define PG8_WAIT_V(n) asm volatile("s_waitcnt vmcnt(" #n ")" ::: "memory")
#define PG8_WAIT_L(n) asm volatile("s_waitcnt lgkmcnt(" #n ")" ::: "memory")
#define PG8_BAR __builtin_amdgcn_s_barrier()
#define PG8_SCHED __builtin_amdgcn_sched_barrier(0)
    Unit cur, nxt; int ui = 0;
    if (!S.next(0, cur)) return;
    f32x4 acc[2][2][4][2];
#pragma unroll
    for (int a = 0; a < 2; ++a)
#pragma unroll
        for (int b = 0; b < 2; ++b)
#pragma unroll
            for (int m = 0; m < 4; ++m)
#pragma unroll
                for (int n = 0; n < 2; ++n) acc[a][b][m][n] = (f32x4){0.f, 0.f, 0.f, 0.f};
    bf16x8 At[4][2], B0[2][2], B1[2][2];
    const char* cA = (const char*)g.A + (size_t)cur.pm * tstepA; const char* cB = (const char*)g.Bt + (size_t)cur.pn * tstepB;
    PG8_STAGE(PG8_SB(0, 0), cB, voffB); PG8_STAGE(PG8_SA(0, 0), cA, voffA); PG8_STAGE(PG8_SB(0, 1), cB + hstepB, voffB); PG8_STAGE(PG8_SA(0, 1), cA + hstepA, voffA);
    if (wr == 1) PG8_BAR;
    PG8_WAIT_V(4); PG8_BAR;
    PG8_STAGE(PG8_SB(1, 0), cB + kstep, voffB); PG8_STAGE(PG8_SA(1, 0), cA + kstep, voffA); PG8_STAGE(PG8_SB(1, 1), cB + hstepB + kstep, voffB);
    PG8_WAIT_V(6); PG8_BAR;
    for (;;) {
        const bool has_next = S.next(ui + 1, nxt);
        const char* nA = has_next ? (const char*)g.A + (size_t)nxt.pm * tstepA : cA; const char* nB = has_next ? (const char*)g.Bt + (size_t)nxt.pn * tstepB : cB;
        for (int t = 0; t < nt; t += 2) {
            const bool last = (t == nt - 2);
            const char* a1 = cA + (size_t)(t + 1) * kstep;
            const char* a2 = last ? nA : cA + (size_t)(t + 2) * kstep; const char* b2 = last ? nB : cB + (size_t)(t + 2) * kstep;
            const char* a3 = a2 + kstep; const char* b3 = b2 + kstep;
            PG8_LDB(B0, 0, 0); PG8_SCHED; PG8_LDA(At, 0, 0); PG8_STAGE(PG8_SA(1, 1), a1 + hstepA, voffA);
            PG8_WAIT_L(8); PG8_BAR; PG8_WAIT_L(0); PG8_MMA(0, 0, At, B0); PG8_BAR; PG8_SCHED;
            PG8_LDB(B1, 0, 1); PG8_STAGE(PG8_SB(0, 0), b2, voffB);
            PG8_BAR; PG8_WAIT_L(0); PG8_MMA(0, 1, At, B1); PG8_BAR;
            PG8_LDA(At, 0, 1); PG8_STAGE(PG8_SA(0, 0), a2, voffA);
            PG8_BAR; PG8_WAIT_L(0); PG8_MMA(1, 0, At, B0); PG8_BAR; PG8_SCHED;
            PG8_STAGE(PG8_SB(0, 1), b2 + hstepB, voffB);
            PG8_WAIT_V(6); PG8_BAR; PG8_MMA(1, 1, At, B1); PG8_BAR;
            PG8_LDB(B0, 1, 0); PG8_SCHED; PG8_LDA(At, 1, 0); PG8_STAGE(PG8_SA(0, 1), a2 + hstepA, voffA);
            PG8_WAIT_L(8); PG8_BAR; PG8_WAIT_L(0); PG8_MMA(0, 0, At, B0); PG8_BAR; PG8_SCHED;
            PG8_LDB(B1, 1, 1); PG8_STAGE(PG8_SB(1, 0), b3, voffB);
            PG8_BAR; PG8_WAIT_L(0); PG8_MMA(0, 1, At, B1); PG8_BAR;
            PG8_LDA(At, 1, 1); PG8_STAGE(PG8_SA(1, 0), a3, voffA);
            PG8_BAR; PG8_WAIT_L(0); PG8_MMA(1, 0, At, B0); PG8_BAR; PG8_SCHED;
            PG8_STAGE(PG8_SB(1, 1), b3 + hstepB, voffB);
            PG8_WAIT_V(6); PG8_BAR; PG8_MMA(1, 1, At, B1); PG8_BAR;
        }
        E(acc, cur, wr, wc, fr, fq);
        if (!has_next) break;
#pragma unroll
        for (int a = 0; a < 2; ++a)
#pragma unroll
            for (int b = 0; b < 2; ++b)
#pragma unroll
                for (int m = 0; m < 4; ++m)
#pragma unroll
                    for (int n = 0; n < 2; ++n) acc[a][b][m][n] = (f32x4){0.f, 0.f, 0.f, 0.f};
        cur = nxt; cA = nA; cB = nB; ++ui;
    }
    PG8_WAIT_V(0);
    if (wr == 0) PG8_BAR;
    PG8_BAR;
#undef PG8_SA
#undef PG8_SB
#undef PG8_STAGE
#undef PG8_LDA
#undef PG8_LDB
#undef PG8_MMA
#undef PG8_WAIT_V
#undef PG8_WAIT_L
#undef PG8_BAR
#undef PG8_SCHED
}
}

struct EpiStoreBf16 {
    static constexpr bool PERM = true;
    bf16_t* O; int ldc;
    __device__ __forceinline__ void operator()(const f32x4 (&acc)[2][2][4][2], const pg8::Unit& u, int wr_, int wc_, int fr_, int fq_) const {
        const int t2_ = otid(), wr = t2_ >> 8, wc = (t2_ >> 6) & 3, fr = t2_ & 15, fq = (t2_ >> 4) & 3; (void)wr_; (void)wc_; (void)fr_; (void)fq_;
        const int row0 = u.pm * 256 + wr * 64 + fr, col0 = u.pn * 256 + wc * 32 + 8 * fq;
#pragma unroll
        for (int ai = 0; ai < 2; ++ai)
#pragma unroll
            for (int m = 0; m < 4; ++m) { bf16_t* rowp = O + (size_t)(row0 + ai * 128 + m * 16) * ldc + col0;
#pragma unroll
                for (int bj = 0; bj < 2; ++bj) { const f32x4 v0 = acc[ai][bj][m][0], v1 = acc[ai][bj][m][1];
                    u32x4 w; w.x = cvt_pk_bf16(v0[0], v0[1]); w.y = cvt_pk_bf16(v0[2], v0[3]); w.z = cvt_pk_bf16(v1[0], v1[1]); w.w = cvt_pk_bf16(v1[2], v1[3]);
                    *(u32x4*)(rowp + bj * 128) = w; } }
    }
};
struct EpiGlu {
    static constexpr bool PERM = true;
    const bf16_t* Z; bf16_t* MIX; const float* bias;
    __device__ __forceinline__ void operator()(const f32x4 (&acc)[2][2][4][2], const pg8::Unit& u, int wr_, int wc_, int fr_, int fq_) const {
        const int t2_ = otid(), wr = t2_ >> 8, wc = (t2_ >> 6) & 3, fr = t2_ & 15, fq = (t2_ >> 4) & 3; (void)wr_; (void)wc_; (void)fr_; (void)fq_;
        const int row0 = u.pm * 256 + wr * 64 + fr, col0 = u.pn * 256 + wc * 32 + 8 * fq;
#pragma unroll
        for (int ai = 0; ai < 2; ++ai)
#pragma unroll
            for (int m = 0; m < 4; ++m) { const int row = row0 + ai * 128 + m * 16;
#pragma unroll
                for (int bj = 0; bj < 2; ++bj) { const int col = col0 + bj * 128;
                    const f32x4 b0 = *(const f32x4*)(bias + col), b1 = *(const f32x4*)(bias + col + 4);
                    const f32x4 v0 = acc[ai][bj][m][0] + b0, v1 = acc[ai][bj][m][1] + b1;
                    const u32x4 z = *(const u32x4*)(Z + (size_t)row * 512 + col);
                    u32x4 w;
                    w.x = cvt_pk_bf16(bflo(z.x) * sigmoidf_(v0[0]), bfhi(z.x) * sigmoidf_(v0[1]));
                    w.y = cvt_pk_bf16(bflo(z.y) * sigmoidf_(v0[2]), bfhi(z.y) * sigmoidf_(v0[3]));
                    w.z = cvt_pk_bf16(bflo(z.z) * sigmoidf_(v1[0]), bfhi(z.z) * sigmoidf_(v1[1]));
                    w.w = cvt_pk_bf16(bflo(z.w) * sigmoidf_(v1[2]), bfhi(z.w) * sigmoidf_(v1[3]));
                    *(u32x4*)(MIX + (size_t)row * 2048 + 1536 + col) = w; } }
    }
};
struct EpiResid {
    static constexpr bool PERM = false;
    const float* srcL; const float* srcC; float* dstL; float* dstC; const float* modsel;
    __device__ __forceinline__ void operator()(const f32x4 (&acc)[2][2][4][2], const pg8::Unit& u, int wr_, int wc_, int fr_, int fq_) const {
        const int t2_ = otid(), wr = t2_ >> 8, wc = (t2_ >> 6) & 3, fr = t2_ & 15, fq = (t2_ >> 4) & 3; (void)wr_; (void)wc_; (void)fr_; (void)fq_;
        const int rbase = u.pm * 256;
        const bool isc = rbase >= RL;
        const int mr = isc ? 4 : (rbase >> 12);
        const float* gate = modsel + (size_t)mr * 12288;
        const float* src = isc ? srcC - (size_t)RL * 2048 : srcL;
        float* dst = isc ? dstC - (size_t)RL * 2048 : dstL;
        const int row0 = rbase + wr * 64 + fr, col0 = u.pn * 256 + wc * 32 + 4 * fq;
#pragma unroll
        for (int ai = 0; ai < 2; ++ai)
#pragma unroll
            for (int m = 0; m < 4; ++m) { const size_t ro = (size_t)(row0 + ai * 128 + m * 16) * 2048;
#pragma unroll
                for (int bj = 0; bj < 2; ++bj)
#pragma unroll
                    for (int n = 0; n < 2; ++n) { const int col = col0 + bj * 128 + n * 16;
                        const f32x4 gg = *(const f32x4*)(gate + col), s = *(const f32x4*)(src + ro + col);
                        *(f32x4*)(dst + ro + col) = s + gg * acc[ai][bj][m][n]; } }
    }
};

struct EpiResidAtomic {
    static constexpr bool PERM = false;
    float* dstC; const float* gate;
    __device__ __forceinline__ void operator()(const f32x4 (&acc)[2][2][4][2], const pg8::Unit& u, int wr_, int wc_, int fr_, int fq_) const {
        const int t2_ = otid(), wr = t2_ >> 8, wc = (t2_ >> 6) & 3, fr = t2_ & 15, fq = (t2_ >> 4) & 3; (void)wr_; (void)wc_; (void)fr_; (void)fq_;
        float* dst = dstC - (size_t)RL * 2048;
        const int row0 = u.pm * 256 + wr * 64 + fr, col0 = u.pn * 256 + wc * 32 + 4 * fq;
#pragma unroll
        for (int ai = 0; ai < 2; ++ai)
#pragma unroll
            for (int m = 0; m < 4; ++m) { const size_t ro = (size_t)(row0 + ai * 128 + m * 16) * 2048;
#pragma unroll
                for (int bj = 0; bj < 2; ++bj)
#pragma unroll
                    for (int n = 0; n < 2; ++n) { const int col = col0 + bj * 128 + n * 16;
                        const f32x4 v = *(const f32x4*)(gate + col) * acc[ai][bj][m][n];
                        __hip_atomic_fetch_add(dst + ro + col, v[0], __ATOMIC_RELAXED, __HIP_MEMORY_SCOPE_AGENT); __hip_atomic_fetch_add(dst + ro + col + 1, v[1], __ATOMIC_RELAXED, __HIP_MEMORY_SCOPE_AGENT);
                        __hip_atomic_fetch_add(dst + ro + col + 2, v[2], __ATOMIC_RELAXED, __HIP_MEMORY_SCOPE_AGENT); __hip_atomic_fetch_add(dst + ro + col + 3, v[3], __ATOMIC_RELAXED, __HIP_MEMORY_SCOPE_AGENT); } }
    }
};

#define PHYS(i) ((i) + ((i) >> 4))
template <int R, bool INV>
__device__ __forceinline__ void fft_pass(LAS c2* buf, int logN, int s_lo, const LAS c2* twab, int ht) {
    const int N = 1 << logN, ngroups = N >> R, tshift = 13 - logN;
    constexpr int NE = 1 << R;
    constexpr float RH = 0.70710678118654752f;
#pragma unroll 2
    for (int q = ht; q < ngroups; q += 256) {
        const int qlo = q & (s_lo - 1), base = ((q - qlo) << R) + qlo;
        c2 x[NE];
#pragma unroll
        for (int k = 0; k < NE; ++k) x[k] = buf[PHYS(base + k * s_lo)];
#pragma unroll
        for (int u = 0; u < R; ++u) {
            const int h = INV ? (1 << u) : (1 << (R - 1 - u));
            const int e = (qlo * (N / (2 * h * s_lo))) << tshift;
            const c2 T = cmul(twab[e >> 6], twab[64 + (e & 63)]);
#pragma unroll
            for (int k = 0; k < NE; ++k) {
                if (k & h) continue;
                const int j8 = (k & (h - 1)) * (4 / h);
                const float cr = (j8 == 0) ? 1.f : (j8 == 1) ? RH : (j8 == 2) ? 0.f : -RH;
                const float ci = (j8 == 0) ? 0.f : (j8 == 1) ? -RH : (j8 == 2) ? -1.f : -RH;
                const c2 w = cmul(T, mkc2(cr, ci));
                if (!INV) { const c2 a = x[k], b = x[k + h]; x[k] = mkc2(a.x + b.x, a.y + b.y); x[k + h] = cmul(mkc2(a.x - b.x, a.y - b.y), w); }
                else { const c2 a = x[k], b = cmulc(x[k + h], w); x[k] = mkc2(a.x + b.x, a.y + b.y); x[k + h] = mkc2(a.x - b.x, a.y - b.y); }
            }
        }
#pragma unroll
        for (int k = 0; k < NE; ++k) buf[PHYS(base + k * s_lo)] = x[k];
    }
}
__device__ __forceinline__ void fft_fwd(LAS c2* buf, int logN, const LAS c2* tw, int ht) {
    __syncthreads();
    if (logN == 13) {
        fft_pass<3, false>(buf, 13, 1024, tw, ht); __syncthreads();
        fft_pass<3, false>(buf, 13, 128, tw, ht); __syncthreads();
        fft_pass<3, false>(buf, 13, 16, tw, ht); __syncthreads();
        fft_pass<3, false>(buf, 13, 2, tw, ht); __syncthreads();
        fft_pass<1, false>(buf, 13, 1, tw, ht); __syncthreads();
    } else {
        fft_pass<3, false>(buf, 9, 64, tw, ht); __syncthreads();
        fft_pass<3, false>(buf, 9, 8, tw, ht); __syncthreads();
        fft_pass<3, false>(buf, 9, 1, tw, ht); __syncthreads();
    }
}
__device__ __forceinline__ void fft_inv(LAS c2* buf, int logN, const LAS c2* tw, int ht) {
    __syncthreads();
    if (logN == 13) {
        fft_pass<1, true>(buf, 13, 1, tw, ht); __syncthreads();
        fft_pass<3, true>(buf, 13, 2, tw, ht); __syncthreads();
        fft_pass<3, true>(buf, 13, 16, tw, ht); __syncthreads();
        fft_pass<3, true>(buf, 13, 128, tw, ht); __syncthreads();
        fft_pass<3, true>(buf, 13, 1024, tw, ht); __syncthreads();
    } else {
        fft_pass<3, true>(buf, 9, 1, tw, ht); __syncthreads();
        fft_pass<3, true>(buf, 9, 8, tw, ht); __syncthreads();
        fft_pass<3, true>(buf, 9, 64, tw, ht); __syncthreads();
    }
}

__device__ __forceinline__ void fft_conv13(LAS c2* buf, const c2* __restrict__ KF, const LAS c2* tw, int ht) {
    __syncthreads();
    fft_pass<3, false>(buf, 13, 1024, tw, ht); __syncthreads();
    fft_pass<3, false>(buf, 13, 128, tw, ht); __syncthreads();
    fft_pass<3, false>(buf, 13, 16, tw, ht); __syncthreads();
    fft_pass<3, false>(buf, 13, 2, tw, ht); __syncthreads();
#pragma unroll 1
    for (int q = ht; q < 4096; q += 256) { const c2 x0 = buf[PHYS(2 * q)], x1 = buf[PHYS(2 * q + 1)]; const f32x4 kk = *(const f32x4*)(KF + 2 * q);
        const c2 a = cmul(mkc2(x0.x + x1.x, x0.y + x1.y), mkc2(kk[0], kk[1])), b = cmul(mkc2(x0.x - x1.x, x0.y - x1.y), mkc2(kk[2], kk[3]));
        buf[PHYS(2 * q)] = mkc2(a.x + b.x, a.y + b.y); buf[PHYS(2 * q + 1)] = mkc2(a.x - b.x, a.y - b.y); }
    __syncthreads();
    fft_pass<3, true>(buf, 13, 2, tw, ht); __syncthreads();
    fft_pass<3, true>(buf, 13, 16, tw, ht); __syncthreads();
    fft_pass<3, true>(buf, 13, 128, tw, ht); __syncthreads();
    fft_pass<3, true>(buf, 13, 1024, tw, ht); __syncthreads();
}

__device__ __forceinline__ void phase_p0(PRef p, unsigned char* shm) {
    const int tid = otid(), lane = tid & 63, wave = tid >> 6;
    float* mod = (float*)(p.ws + O_MOD); float* hid = (float*)(p.ws + O_HID);
    if (blockIdx.x == 0) for (int i = tid; i < 64 + 2048; i += 512) ((unsigned*)(p.ws + O_QCTR))[i] = 0u;
    { const float4* src = (const float4*)p.in[2]; float4* dst = (float4*)(p.ws + O_HCTX);
      for (int i = blockIdx.x * 512 + tid; i < RC * 2048 / 4; i += gridDim.x * 512) dst[i] = src[i]; }
    constexpr int N_MODIT = 768, N_HIDIT = 1088;
    float* sl = (float*)shm;
    float* part = sl + 5 * 2048;
    for (int it = blockIdx.x; it < N_MODIT + N_HIDIT; it += gridDim.x) {
        if (it < N_MODIT) {
            const int layer = it / 384, col0 = (it % 384) * 32;
#pragma unroll 10
            for (int i = tid; i < 5 * 2048; i += 512) { const int r = i >> 11, k = i & 2047; const float v = r < 4 ? p.in[1][r * 2048 + k] : p.in[3][k]; sl[i] = v * sigmoidf_(v); }
            __syncthreads();
            const int cl = tid & 31, kg = tid >> 5;
            const float* W = p.in[4] + ((size_t)layer * 2048 + kg * 128) * 12288 + col0 + cl;
            float a0 = 0.f, a1 = 0.f, a2 = 0.f, a3 = 0.f, a4 = 0.f;
#pragma unroll 16
            for (int k = 0; k < 128; ++k) { const float w = W[(size_t)k * 12288]; const int kk = kg * 128 + k;
                a0 += sl[kk] * w; a1 += sl[2048 + kk] * w; a2 += sl[4096 + kk] * w; a3 += sl[6144 + kk] * w; a4 += sl[8192 + kk] * w; }
            part[(kg * 5 + 0) * 32 + cl] = a0; part[(kg * 5 + 1) * 32 + cl] = a1; part[(kg * 5 + 2) * 32 + cl] = a2; part[(kg * 5 + 3) * 32 + cl] = a3; part[(kg * 5 + 4) * 32 + cl] = a4;
            __syncthreads();
            if (tid < 160) { const int r = tid >> 5, cc = tid & 31; float s = p.in[5][layer * 12288 + col0 + cc];
                for (int g = 0; g < 16; ++g) s += part[(g * 5 + r) * 32 + cc];
                mod[(size_t)(layer * 5 + r) * 12288 + col0 + cc] = s; }
            __syncthreads();
        } else {
            const int pi = (it - N_MODIT) * 8 + wave;
            const int layer = pi / 4352, q = pi % 4352;
            const int len = q < 4096 ? 4096 : 256, l = q < 4096 ? q : q - 4096;
            const float t = (float)l / (float)(len - 1);
            const float angb = (6.283185307179586f * (float)l) / (float)len;
            const float* w1 = p.in[10] + layer * 33 * 64; const float* w2 = p.in[12] + layer * 64 * 64;
            float pre = p.in[11][layer * 64 + lane] + t * w1[lane];
#pragma unroll 4
            for (int e = 0; e < 16; ++e) { const float band = 1e-4f + (float)e * ((15.f - 1e-4f) / 15.f); float s, c; sincosf(angb * band, &s, &c);
                pre += c * w1[(1 + e) * 64 + lane] - s * w1[(17 + e) * 64 + lane]; }
            const float h1 = sinf(p.in[15][(layer * 2 + 0) * 64 + lane] * pre);
            float* hb = (float*)shm + wave * 64;
            __syncthreads();
            hb[lane] = h1;
            __syncthreads();
            float pre2 = p.in[13][layer * 64 + lane];
#pragma unroll 16
            for (int i = 0; i < 64; ++i) pre2 += hb[i] * w2[i * 64 + lane];
            hid[(size_t)(layer * 4352 + q) * 64 + lane] = sinf(p.in[15][(layer * 2 + 1) * 64 + lane] * pre2);
            __syncthreads();
        }
    }
}

__device__ __forceinline__ void convT_tile(const float* __restrict__ W, int K, int N, bf16_t* __restrict__ WT, int tile, unsigned char* shm, int wave, int lane) {
    const int ntn = N / 64, k0 = (tile / ntn) * 64, n0 = (tile % ntn) * 64;
    float* T = (float*)shm + wave * (64 * 65);
    { const int r4 = lane >> 4, c4 = (lane & 15) * 4;
#pragma unroll
      for (int i = 0; i < 16; ++i) { const int rr = 4 * i + r4; const float4 v = *(const float4*)(W + (size_t)(k0 + rr) * N + n0 + c4);
          T[rr * 65 + c4] = v.x; T[rr * 65 + c4 + 1] = v.y; T[rr * 65 + c4 + 2] = v.z; T[rr * 65 + c4 + 3] = v.w; } }
    __builtin_amdgcn_fence(__ATOMIC_RELEASE, "wavefront"); __builtin_amdgcn_wave_barrier(); __builtin_amdgcn_fence(__ATOMIC_ACQUIRE, "wavefront");
    { const int n8 = lane >> 3, k8 = (lane & 7) * 8;
#pragma unroll
      for (int i = 0; i < 8; ++i) { const int n = 8 * i + n8; const float* sp = T + k8 * 65 + n;
          u32x4 o; o.x = cvt_pk_bf16(sp[0], sp[65]); o.y = cvt_pk_bf16(sp[2 * 65], sp[3 * 65]); o.z = cvt_pk_bf16(sp[4 * 65], sp[5 * 65]); o.w = cvt_pk_bf16(sp[6 * 65], sp[7 * 65]);
          *(u32x4*)(WT + (size_t)(n0 + n) * K + k0 + k8) = o; } }
    __builtin_amdgcn_fence(__ATOMIC_RELEASE, "wavefront"); __builtin_amdgcn_wave_barrier(); __builtin_amdgcn_fence(__ATOMIC_ACQUIRE, "wavefront");
}

__device__ __forceinline__ void s5prep_item(PRef p, int layer, int g, int part, unsigned char* shm) {
    const int tid = otid();
    c2* pw = (c2*)shm;
    c2* bbar = pw + 2 * 64 * 65;
    c2* cm = bbar + 2 * 64 * 16;
    c2* lamdt = cm + 2 * 16 * 64;
    if (tid < 128) { const int dir = tid >> 6, pp = tid & 63; const int o = ((layer * 2 + dir) * 32 + g) * 64 + pp;
        const float st = expf(p.in[20][(layer * 2 + dir) * 32 + g]);
        lamdt[tid] = mkc2(fminf(p.in[18][o], -1e-4f) * st, p.in[19][o] * st); }
    __syncthreads();
    for (int i = tid; i < 2 * 64 * 65; i += 512) { const int dp = i / 65, d = i % 65; const c2 z = lamdt[dp];
        float s, c; sincosf((float)d * z.y, &s, &c); const float m = expf((float)d * z.x); pw[i] = mkc2(m * c, m * s); }
    for (int i = tid; i < 2 * 64 * 16; i += 512) { const int dp = i >> 4, j = i & 15, dir = dp >> 6, pp = dp & 63;
        const int o = ((layer * 2 + dir) * 32 + g) * 64 + pp; const c2 z = lamdt[dp];
        const float st = expf(p.in[20][(layer * 2 + dir) * 32 + g]);
        const c2 lam = mkc2(fminf(p.in[18][o], -1e-4f), p.in[19][o]);
        float s, c; sincosf(z.y, &s, &c); const float sh = sinf(0.5f * z.y);
        const c2 em1 = mkc2(expm1f(z.x) * c - 2.f * sh * sh, expf(z.x) * s);
        const float den = 1.f / (lam.x * lam.x + lam.y * lam.y);
        const c2 coef = mkc2((em1.x * lam.x + em1.y * lam.y) * den, (em1.y * lam.x - em1.x * lam.y) * den);
        (void)st;
        const c2 bm = mkc2(p.in[21][(size_t)o * 16 + j], p.in[22][(size_t)o * 16 + j]);
        bbar[i] = cmul(coef, bm); }
    for (int i = tid; i < 2 * 16 * 64; i += 512) { const int dir = i >> 10, ii = (i >> 6) & 15, pp = i & 63;
        const size_t o = ((size_t)((layer * 2 + dir) * 32 + g) * 16 + ii) * 64 + pp; cm[i] = mkc2(p.in[23][o], p.in[24][o]); }
    __syncthreads();
    bf16_t* E = (bf16_t*)(p.ws + O_S5E); bf16_t* G = (bf16_t*)(p.ws + O_S5G); bf16_t* KT = (bf16_t*)(p.ws + O_S5K); c2* LT = (c2*)(p.ws + O_S5LT);
    if (part == 0 && tid < 128) { const int dir = tid >> 6, pp = tid & 63; LT[(dir * 32 + g) * 64 + pp] = pw[(dir * 64 + pp) * 65 + 64]; }
    for (int i = tid; i < 2 * 32 * 1024; i += 512) { const int dir = i >> 15, rr = (i >> 10) & 31, k = i & 1023; const int row = part * 32 + rr, pp = row >> 1, ri = row & 1, s = k >> 4, j = k & 15;
        const c2 w = cmul(pw[(dir * 64 + pp) * 65 + (dir == 0 ? 63 - s : s)], bbar[(dir * 64 + pp) * 16 + j]);
        E[((size_t)(dir * 32 + g) * 128 + row) * 1024 + k] = f2bf(ri ? w.y : w.x); }
    for (int i = tid; i < 2 * 256 * 128; i += 512) { const int dir = i >> 15, rr = (i >> 7) & 255, k = i & 127; const int t = part * 16 + (rr >> 4), ii = rr & 15, pp = k >> 1, ri = k & 1;
        const c2 w = cmul(cm[(dir * 16 + ii) * 64 + pp], pw[(dir * 64 + pp) * 65 + (dir == 0 ? t + 1 : 64 - t)]);
        G[((size_t)(dir * 32 + g) * 1024 + t * 16 + ii) * 128 + k] = f2bf(ri ? -w.y : w.x); }
    { const int pair = tid & 255, ii = pair >> 4, j = pair & 15, half = tid >> 8;
      const int dir = part < 2 ? 1 : 0;
      float* psum = (float*)(shm + 100352);
#pragma unroll 1
      for (int ph = 0; ph < 2; ++ph) {
          c2 cb[32];
#pragma unroll
          for (int q = 0; q < 32; ++q) { const int pp = ph * 32 + q; cb[q] = cmul(cm[(dir * 16 + ii) * 64 + pp], bbar[(dir * 64 + pp) * 16 + j]);
              if ((q & 7) == 7) asm volatile("" : "+v"(cb[q].x), "+v"(cb[q].y) :: "memory"); }
#pragma unroll 1
          for (int k = 0; k < 16; ++k) { const int dd = part * 32 + half * 16 + k;
              if (dd > 126) continue;
              const int d = dir ? 63 - dd : dd - 63;
              const c2* pwd = pw + (size_t)(dir * 64 + ph * 32) * 65 + d;
              float acc = ph ? psum[k * 512 + tid] : 0.f;
#pragma unroll
              for (int q = 0; q < 32; ++q) { const c2 w = pwd[q * 65]; acc += cb[q].x * w.x - cb[q].y * w.y;
                  if ((q & 7) == 7) asm volatile("" : "+v"(acc) :: "memory"); }
              if (ph == 0) { psum[k * 512 + tid] = acc; continue; }
              if (dd == 63) {
                  for (int pp = 0; pp < 64; ++pp) { const c2 w = cmul(cm[(0 * 16 + ii) * 64 + pp], bbar[(0 * 64 + pp) * 16 + j]); acc += w.x; } }
              KT[((size_t)g * 127 + dd) * 256 + ii * 16 + j] = f2bf(acc); } } }
    __syncthreads();
}

__device__ __forceinline__ void hyfilter_item(PRef p, int layer, bool isctx, int cg4, unsigned char* shm) {
    const int tid = otid(), hb = tid >> 8, ht = tid & 255, lane = tid & 63, wave = tid >> 6, c0 = cg4 * 4;
    const int L = isctx ? 256 : 4096, logN = isctx ? 9 : 13, N = 2 * L;
    const LAS c2* tw = (const LAS c2*)(shm + SCR_OFF + SCR_TW);
    const float* hid = (const float*)(p.ws + O_HID) + (size_t)(layer * 4352 + (isctx ? 4096 : 0)) * 64;
    c2* KF0b = isctx ? (c2*)(p.ws + O_KFC) + (size_t)c0 * 512 : (c2*)(p.ws + O_KF) + (size_t)c0 * 8192;
    c2* KF1b = isctx ? (c2*)(p.ws + O_KFC) + (size_t)(512 + c0) * 512 : (c2*)(p.ws + O_KF) + (size_t)(512 + c0) * 8192;
    float* red = (float*)shm;
    __syncthreads();
    const int fr = lane & 15, fq = lane >> 4;
    const int cdir = fr >> 3, co = (fr >> 2) & 1, ccc = fr & 3;
    bf16x8 bw[2];
    { const float* wp = p.in[14] + (size_t)layer * 64 * 2048 + cdir * 1024 + co * 512 + c0 + ccc;
#pragma unroll
      for (int kk = 0; kk < 2; ++kk) { float wv[8];
#pragma unroll
          for (int i = 0; i < 8; ++i) wv[i] = wp[(size_t)(kk * 32 + fq * 8 + i) * 2048];
          u32x4 w; w.x = cvt_pk_bf16(wv[0], wv[1]); w.y = cvt_pk_bf16(wv[2], wv[3]); w.z = cvt_pk_bf16(wv[4], wv[5]); w.w = cvt_pk_bf16(wv[6], wv[7]); bw[kk] = mk8(w); } }
    const float mind = -4.605170185988091f / 1.5f, maxd = -4.605170185988091f / 0.3f;
    const float adelta = fabsf(mind + (float)(c0 + ccc) * ((maxd - mind) / 511.f));
    float* ST = (float*)(KF0b + (size_t)ccc * N) + co;
    if (tid < 8) ((float*)(KF0b + (size_t)(tid & 3) * N))[2 * L + (tid >> 2)] = 0.f;
    float l1 = 0.f;
#pragma unroll 4
    for (int dt = wave; dt < L / 16; dt += 8) {
        const float* hr = hid + (size_t)(dt * 16 + fr) * 64 + fq * 8;
        f32x4 acc = (f32x4){0.f, 0.f, 0.f, 0.f};
#pragma unroll
        for (int kk = 0; kk < 2; ++kk) { const f32x4 x0 = *(const f32x4*)(hr + kk * 32), x1 = *(const f32x4*)(hr + kk * 32 + 4);
            u32x4 w; w.x = cvt_pk_bf16(x0[0], x0[1]); w.y = cvt_pk_bf16(x0[2], x0[3]); w.z = cvt_pk_bf16(x1[0], x1[1]); w.w = cvt_pk_bf16(x1[2], x1[3]);
            acc = __builtin_amdgcn_mfma_f32_16x16x32_bf16(mk8(w), bw[kk], acc, 0, 0, 0); }
#pragma unroll
        for (int r = 0; r < 4; ++r) { const int d = dt * 16 + fq * 4 + r; const float t = (float)d / (float)(L - 1);
            const float v = acc[r] * expf(-t * adelta);
            if (cdir == 0) { ST[2 * d] = v; l1 += fabsf(v); }
            else if (d >= 1) { ST[2 * (N - d)] = v; l1 += fabsf(v); } } }
    l1 += __shfl_xor(l1, 16); l1 += __shfl_xor(l1, 32);
    if (lane < 16) red[wave * 16 + lane] = l1;
    __threadfence();
    __syncthreads();
    __builtin_amdgcn_fence(__ATOMIC_ACQUIRE, "agent");
    LAS float* tot = (LAS float*)(shm + SCR_OFF);
    if (tid < 8) { float v = 0.f;
#pragma unroll
        for (int w = 0; w < 8; ++w) v += red[w * 16 + tid] + red[w * 16 + 8 + tid];
        tot[tid] = v; }
    __syncthreads();
    LAS c2* buf = (LAS c2*)shm + hb * FFT_PAD;
#pragma unroll 1
    for (int pr = 0; pr < 2; ++pr) { const int cc = 2 * pr + hb;
        const float inv0 = 0.5f / (tot[cc] * (float)N), inv1 = 0.5f / (tot[4 + cc] * (float)N);
        const c2* Z = KF0b + (size_t)cc * N;
#pragma unroll 8
        for (int i = ht; i < N; i += 256) buf[PHYS(i)] = Z[i];
        fft_fwd(buf, logN, tw, ht);
        c2* K0 = KF0b + (size_t)cc * N; c2* K1 = KF1b + (size_t)cc * N;
#pragma unroll 4
        for (int q = ht; q < N; q += 256) {
            const unsigned f = __brev((unsigned)q) >> (32 - logN);
            const unsigned q2 = __brev(((unsigned)N - f) & (unsigned)(N - 1)) >> (32 - logN);
            const c2 za = buf[PHYS(q)], zb = buf[PHYS((int)q2)];
            K0[q] = mkc2((za.x + zb.x) * inv0, (za.y - zb.y) * inv0);
            K1[q] = mkc2((za.y + zb.y) * inv1, (zb.x - za.x) * inv1); }
        __syncthreads(); }
}

__device__ __forceinline__ void xn_row(const float* hrow, const float* g, const float* shift, const float* scale, bf16_t* orow, int lane) {
    const float4* xr = (const float4*)hrow + lane;
    float4 v[8]; float s = 0.f;
#pragma unroll
    for (int j = 0; j < 8; ++j) { v[j] = xr[64 * j]; s += v[j].x * v[j].x + v[j].y * v[j].y + v[j].z * v[j].z + v[j].w * v[j].w; }
    const float r = rsqrtf(wave_sum(s) * (1.f / D) + 1e-6f);
    u32x2* o = (u32x2*)orow + lane;
#pragma unroll
    for (int j = 0; j < 8; ++j) { const float4 gg = ((const float4*)g)[lane + 64 * j], sh = ((const float4*)shift)[lane + 64 * j], sc = ((const float4*)scale)[lane + 64 * j];
        u32x2 w; w.x = cvt_pk_bf16(v[j].x * r * gg.x * (1.f + sc.x) + sh.x, v[j].y * r * gg.y * (1.f + sc.y) + sh.y);
        w.y = cvt_pk_bf16(v[j].z * r * gg.z * (1.f + sc.z) + sh.z, v[j].w * r * gg.w * (1.f + sc.w) + sh.w);
        o[64 * j] = w; }
}
__device__ __forceinline__ void xn_row1(PRef p, int layer, int which  , int row, int lane, const float* hL, const float* hC) {
    const float* mod = (const float*)(p.ws + O_MOD);
    const bool isc = row >= RL; const int mr = isc ? 4 : (row >> 12);
    const float* m = mod + (size_t)(layer * 5 + mr) * 12288 + (which ? 3 * 2048 : 0);
    const float* hrow = isc ? hC + (size_t)(row - RL) * 2048 : hL + (size_t)row * 2048;
    xn_row(hrow, p.in[which ? 29 : 6] + layer * 2048, m, m + 2048, (bf16_t*)(p.ws + O_XN) + (size_t)row * 2048, lane);
}

__device__ __forceinline__ void phase_lprep(PRef p, int layer, unsigned char* shm, const float* hL_, const float* hC_) {
    constexpr int N_S5 = 128, T_IN = 32 * 80, T_OUT = 32 * 32, T_UP = 32 * 176, T_DOWN = 88 * 32, T_GLU = 64;
    const int tid = otid(), wave = tid >> 6, lane = tid & 63, gw = blockIdx.x * 8 + wave, ngw = gridDim.x * 8;
    for (int rep = 0; rep < NREP(11); ++rep)
    for (int it = blockIdx.x; it < 384 + N_S5; it += gridDim.x) {
        int r = it;
        if (r >= 256 && r < 384) continue;
        if (r < 256) {
#if EN_HY
            const bool isctx = r >= 128; const int q = r & 127; if (!isctx || layer == 0) hyfilter_item(p, layer, isctx, q, shm);
#endif
            continue; }
        r -= 384;
#if EN_S5
        s5prep_item(p, layer, r >> 2, r & 3, shm);
#endif
    }
    __syncthreads();
    constexpr int NT = T_IN + T_OUT + T_UP + T_DOWN + T_GLU;
    for (int rep = 0; rep < NREP(12); ++rep)
    for (int it = gw; it < NT; it += ngw) {
        int r = it;
        if (r < T_IN) { convT_tile(p.in[7] + (size_t)layer * 2048 * 5120, 2048, 5120, (bf16_t*)(p.ws + O_WT_IN), r, shm, wave, lane); continue; } r -= T_IN;
        if (r < T_OUT) { convT_tile(p.in[28] + (size_t)layer * 2048 * 2048, 2048, 2048, (bf16_t*)(p.ws + O_WT_OUT), r, shm, wave, lane); continue; } r -= T_OUT;
        if (r < T_UP) { convT_tile(p.in[30] + (size_t)layer * 2048 * 11264, 2048, 11264, (bf16_t*)(p.ws + O_WT_UP), r, shm, wave, lane); continue; } r -= T_UP;
        if (r < T_DOWN) { convT_tile(p.in[33] + (size_t)layer * 5632 * 2048, 5632, 2048, (bf16_t*)(p.ws + O_WT_DOWN), r, shm, wave, lane); continue; } r -= T_DOWN;
        convT_tile(p.in[26] + (size_t)layer * 512 * 512, 512, 512, (bf16_t*)(p.ws + O_WT_GLU), r, shm, wave, lane);
    }
    for (int row = gw; row < RT; row += ngw) xn_row1(p, layer, 0, row, lane, hL_, hC_);
}

__device__ __forceinline__ void wave_sync_lds() { __builtin_amdgcn_fence(__ATOMIC_RELEASE, "wavefront"); __builtin_amdgcn_wave_barrier(); __builtin_amdgcn_fence(__ATOMIC_ACQUIRE, "wavefront"); }
__device__ __forceinline__ void hyT_witem(PRef p, int layer, bool isctx, int tile, unsigned char* shm, int wave, int lane) {
    const int L = isctx ? 256 : 4096, ntt = L / 32;
    const int b = tile / (ntt * 48), rem = tile % (ntt * 48), t0 = (rem / 48) * 32, c0 = (rem % 48) * 32;
    const bf16_t* A = (const bf16_t*)(p.ws + O_A) + (size_t)(isctx ? RL + b * 256 : b * 4096) * NIN;
    bf16_t* T = isctx ? (bf16_t*)(p.ws + O_HYTC) : (bf16_t*)(p.ws + O_HYT);
    float* X = (float*)shm + wave * (34 * 33);
#pragma unroll
    for (int i = 0; i < 3; ++i) { const int rr = 16 * i + (lane >> 2), c8 = (lane & 3) * 8, t = t0 - 1 + rr;
        if (rr < 34) { u32x4 v = (u32x4){0u, 0u, 0u, 0u};
            if (t >= 0 && t < L) v = *(const u32x4*)(A + (size_t)t * NIN + c0 + c8);
            float* d = X + rr * 33 + c8; d[0] = bflo(v.x); d[1] = bfhi(v.x); d[2] = bflo(v.y); d[3] = bfhi(v.y); d[4] = bflo(v.z); d[5] = bfhi(v.z); d[6] = bflo(v.w); d[7] = bfhi(v.w); } }
    wave_sync_lds();
    { const int cl = lane >> 1, t16 = (lane & 1) * 16, c = c0 + cl;
      const float w0 = p.in[8][(layer * 3 + 0) * 1536 + c], w1 = p.in[8][(layer * 3 + 1) * 1536 + c], w2 = p.in[8][(layer * 3 + 2) * 1536 + c], bb = p.in[9][layer * 1536 + c];
      float o[16];
#pragma unroll
      for (int j = 0; j < 16; ++j) { const int rr = t16 + j + 1; o[j] = w0 * X[(rr - 1) * 33 + cl] + w1 * X[rr * 33 + cl] + w2 * X[(rr + 1) * 33 + cl] + bb; }
      u32x4 wa, wb; wa.x = cvt_pk_bf16(o[0], o[1]); wa.y = cvt_pk_bf16(o[2], o[3]); wa.z = cvt_pk_bf16(o[4], o[5]); wa.w = cvt_pk_bf16(o[6], o[7]);
      wb.x = cvt_pk_bf16(o[8], o[9]); wb.y = cvt_pk_bf16(o[10], o[11]); wb.z = cvt_pk_bf16(o[12], o[13]); wb.w = cvt_pk_bf16(o[14], o[15]);
      bf16_t* dst = T + ((size_t)(b * 1536 + c)) * L + t0 + t16;
      *(u32x4*)dst = wa; *(u32x4*)(dst + 8) = wb; }
    wave_sync_lds();
}

constexpr int LDK = 136;
__device__ __forceinline__ void retkv_item(PRef p, int layer, int item, unsigned char* shm) {
    const int tid = otid(), lane = tid & 63, wave = tid >> 6, fr = lane & 15, fq = lane >> 4;
    int b, h, n, row0, cidx;
    if (item < 1024) { b = item >> 8; h = (item >> 5) & 7; n = item & 31; row0 = b * 4096 + n * 128; cidx = 2 + n; }
    else { const int q = item - 1024; b = q >> 4; h = (q >> 1) & 7; n = q & 1; row0 = RL + b * 256 + n * 128; cidx = n; }
    const float lgf = -expf(p.in[17][(layer * 2 + 0) * 8 + h]), lgb = -expf(p.in[17][(layer * 2 + 1) * 8 + h]);
    const bf16_t* A = (const bf16_t*)(p.ws + O_A);
    bf16_t* kTf = (bf16_t*)shm; bf16_t* kTb = kTf + 64 * LDK; bf16_t* vT = kTb + 64 * LDK;
#pragma unroll
    for (int i = 0; i < 2; ++i) { const int idx = tid + 512 * i, m = idx >> 3, d8 = (idx & 7) * 8;
        const u32x4 v = *(const u32x4*)(A + (size_t)(row0 + m) * NIN + C_K + h * 64 + d8);
        const float pf = 0.125f * expf((float)(127 - m) * lgf), pb = 0.125f * expf((float)m * lgb);
        const unsigned ww[4] = {v.x, v.y, v.z, v.w};
#pragma unroll
        for (int j = 0; j < 4; ++j) { const float lo = bflo(ww[j]), hi = bfhi(ww[j]);
            kTf[(d8 + 2 * j) * LDK + m] = f2bf(lo * pf); kTf[(d8 + 2 * j + 1) * LDK + m] = f2bf(hi * pf);
            kTb[(d8 + 2 * j) * LDK + m] = f2bf(lo * pb); kTb[(d8 + 2 * j + 1) * LDK + m] = f2bf(hi * pb); } }
#pragma unroll
    for (int i = 0; i < 4; ++i) { const int idx = tid + 512 * i, m = idx >> 4, e8 = (idx & 15) * 8;
        const u32x4 v = *(const u32x4*)(A + (size_t)(row0 + m) * NIN + C_V + h * 128 + e8);
        const unsigned ww[4] = {v.x, v.y, v.z, v.w};
#pragma unroll
        for (int j = 0; j < 4; ++j) { vT[(e8 + 2 * j) * LDK + m] = (bf16_t)(ww[j] & 0xffffu); vT[(e8 + 2 * j + 1) * LDK + m] = (bf16_t)(ww[j] >> 16); } }
    __syncthreads();
    const int dir = wave >> 2, mt = wave & 3;
    const bf16_t* kT = dir ? kTb : kTf;
    f32x4 acc[8];
#pragma unroll
    for (int nt = 0; nt < 8; ++nt) acc[nt] = (f32x4){0.f, 0.f, 0.f, 0.f};
#pragma unroll
    for (int kk = 0; kk < 4; ++kk) { const bf16x8 af = *(const bf16x8*)(kT + (16 * mt + fr) * LDK + kk * 32 + fq * 8);
#pragma unroll
        for (int nt = 0; nt < 8; ++nt) { const bf16x8 bf = *(const bf16x8*)(vT + (16 * nt + fr) * LDK + kk * 32 + fq * 8);
            acc[nt] = __builtin_amdgcn_mfma_f32_16x16x32_bf16(af, bf, acc[nt], 0, 0, 0); } }
    float* ST = (float*)(p.ws + O_RETST) + ((size_t)((b * 8 + h) * 2 + dir) * 34 + cidx) * 8192;
#pragma unroll
    for (int nt = 0; nt < 8; ++nt)
#pragma unroll
        for (int r = 0; r < 4; ++r) ST[(16 * mt + fq * 4 + r) * 128 + 16 * nt + fr] = acc[nt][r];
    __syncthreads();
}

__device__ __forceinline__ bf16x8 s5_ufrag(const bf16_t* A, int b, int g, int nt, int kk, int fr, int fq) {
    const int s = 2 * kk + (fq >> 1);
    const int row = (nt < 4) ? (b * 4096 + (16 * nt + fr) * 64 + s) : (RL + b * 256 + (fr & 3) * 64 + s);
    return *(const bf16x8*)(A + (size_t)row * NIN + C_U + g * 16 + (fq & 1) * 8);
}
constexpr int S5_UP = 2064;
__device__ __forceinline__ void s5_stage_u(const bf16_t* A, unsigned char* ul, int b, int g, int nt, int tid) {
#pragma unroll
    for (int i = 0; i < 4; ++i) { const int idx = tid + 512 * i, half = idx & 1, tok = (idx >> 1) & 63, ch = idx >> 7;
        const int row = (nt < 4) ? (b * 4096 + (16 * nt + ch) * 64 + tok) : (RL + b * 256 + (ch & 3) * 64 + tok);
        *(u32x4*)(ul + ch * S5_UP + tok * 32 + half * 16) = *(const u32x4*)(A + (size_t)row * NIN + C_U + g * 16 + half * 8); }
}
__device__ __forceinline__ void s5inc_item(PRef p, int item, unsigned char* shm) {
    const int tid = otid(), lane = tid & 63, wave = tid >> 6, fr = lane & 15, fq = lane >> 4;
    const int g = item >> 3, dir = (item >> 2) & 1, b = item & 3;
    const bf16_t* A = (const bf16_t*)(p.ws + O_A);
    const bf16_t* E = (const bf16_t*)(p.ws + O_S5E) + ((size_t)(dir * 32 + g) * 128 + 16 * wave + fr) * 1024 + fq * 8;
    bf16x8 af[32];
#pragma unroll
    for (int kk = 0; kk < 32; ++kk) af[kk] = *(const bf16x8*)(E + kk * 32);
    float* ST = (float*)(p.ws + O_S5ST) + (size_t)((g * 2 + dir) * 4 + b) * 68 * 128;
#pragma unroll 1
    for (int nt = 0; nt < 5; ++nt) {
        __syncthreads();
        s5_stage_u(A, shm, b, g, nt, tid);
        __syncthreads();
        f32x4 acc = (f32x4){0.f, 0.f, 0.f, 0.f};
#pragma unroll
        for (int kk = 0; kk < 32; ++kk) acc = __builtin_amdgcn_mfma_f32_16x16x32_bf16(af[kk], *(const bf16x8*)(shm + fr * S5_UP + kk * 64 + fq * 16), acc, 0, 0, 0);
        if (nt < 4 || fr < 4) { const int cidx = nt < 4 ? 4 + 16 * nt + fr : fr; *(f32x4*)(ST + (size_t)cidx * 128 + 16 * wave + fq * 4) = acc; }
    }
    __syncthreads();
}

__device__ __forceinline__ void phase_m1(PRef p, int layer, unsigned char* shm) {
    constexpr int N_RKV = 1088, N_S5I = 256;
    for (int it = blockIdx.x; it < N_S5I + N_RKV; it += gridDim.x) {
        int r = it;
        if (r < N_S5I) {
#if EN_S5
            for (int rep = 0; rep < NREP(8); ++rep) s5inc_item(p, r, shm);
#endif
            continue; }
        r -= N_S5I;
#if EN_RET
        for (int rep = 0; rep < NREP(9); ++rep) retkv_item(p, layer, r, shm);
#endif
    }
    __syncthreads();
#if EN_HY
    const int n_hyt = (layer == 0) ? 24576 + 1536 : 24576;
    const int tid = otid(), wave = tid >> 6, lane = tid & 63;
    for (int it = blockIdx.x * 8 + wave; it < n_hyt; it += gridDim.x * 8)
        for (int rep = 0; rep < NREP(10); ++rep) { if (it < 24576) hyT_witem(p, layer, false, it, shm, wave, lane); else hyT_witem(p, layer, true, it - 24576, shm, wave, lane); }
#endif
}

__device__ __forceinline__ void unpack8(u32x4 v, float (&o)[8]) { o[0] = bflo(v.x); o[1] = bfhi(v.x); o[2] = bflo(v.y); o[3] = bfhi(v.y); o[4] = bflo(v.z); o[5] = bfhi(v.z); o[6] = bflo(v.w); o[7] = bfhi(v.w); }
template <bool isctx>
__device__ __forceinline__ void hyconv_item(PRef p, int layer, int item, unsigned char* shm) {
    const int tid = otid(), hb = tid >> 8, ht = tid & 255;
    const int bp = item >> 8, c = 2 * (item & 255) + hb, b0 = 2 * bp, b1 = b0 + 1;
    const int L = isctx ? 256 : 4096, logN = isctx ? 9 : 13, N = 2 * L;
    LAS c2* buf = (LAS c2*)shm + hb * FFT_PAD;
    const LAS c2* tw = (const LAS c2*)(shm + SCR_OFF + SCR_TW);
    const bf16_t* T = isctx ? (const bf16_t*)(p.ws + O_HYTC) : (const bf16_t*)(p.ws + O_HYT);
    float* Y = isctx ? (float*)(p.ws + O_HYYC) : (float*)(p.ws + O_HYY);
    const c2* KF0 = isctx ? (const c2*)(p.ws + O_KFC) + (size_t)c * 512 : (const c2*)(p.ws + O_KF) + (size_t)c * 8192;
    const c2* KF1 = isctx ? (const c2*)(p.ws + O_KFC) + (size_t)(512 + c) * 512 : (const c2*)(p.ws + O_KF) + (size_t)(512 + c) * 8192;
    const bf16_t* v0 = T + (size_t)(b0 * 1536 + c) * L; const bf16_t* v1 = T + (size_t)(b1 * 1536 + c) * L;
    float* y0 = Y + (size_t)(b0 * 512 + c) * L; float* y1 = Y + (size_t)(b1 * 512 + c) * L;
    const float bias0 = p.in[16][(layer * 2 + 0) * 512 + c], bias1 = p.in[16][(layer * 2 + 1) * 512 + c];
    __syncthreads();
#pragma unroll 1
    for (int t8 = ht * 8; t8 < L; t8 += 2048) { float a[8], b[8]; unpack8(*(const u32x4*)(v0 + t8), a); unpack8(*(const u32x4*)(v1 + t8), b);
#pragma unroll
        for (int j = 0; j < 8; ++j) { buf[PHYS(t8 + j)] = mkc2(a[j], b[j]); buf[PHYS(t8 + j + L)] = mkc2(0.f, 0.f); } }
    if (!isctx) fft_conv13(buf, KF0, tw, ht);
    else { fft_fwd(buf, logN, tw, ht);
#pragma unroll 2
        for (int i = ht; i < N; i += 256) buf[PHYS(i)] = cmul(buf[PHYS(i)], KF0[i]);
        fft_inv(buf, logN, tw, ht); }
#pragma unroll 1
    for (int t8 = ht * 8; t8 < L; t8 += 2048) { float a[8], b[8], xa[8], xb[8];
        unpack8(*(const u32x4*)(v0 + t8), a); unpack8(*(const u32x4*)(v1 + t8), b);
        unpack8(*(const u32x4*)(v0 + (size_t)512 * L + t8), xa); unpack8(*(const u32x4*)(v1 + (size_t)512 * L + t8), xb);
        float za[8], zb[8];
#pragma unroll
        for (int j = 0; j < 8; ++j) { const c2 cv = buf[PHYS(t8 + j)]; za[j] = xa[j] * (cv.x + bias0 * a[j]); zb[j] = xb[j] * (cv.y + bias0 * b[j]);
            buf[PHYS(t8 + j)] = mkc2(za[j], zb[j]); buf[PHYS(t8 + j + L)] = mkc2(0.f, 0.f); }
        *(float4*)(y0 + t8) = make_float4(za[0], za[1], za[2], za[3]); *(float4*)(y0 + t8 + 4) = make_float4(za[4], za[5], za[6], za[7]);
        *(float4*)(y1 + t8) = make_float4(zb[0], zb[1], zb[2], zb[3]); *(float4*)(y1 + t8 + 4) = make_float4(zb[4], zb[5], zb[6], zb[7]); }
    if (!isctx) fft_conv13(buf, KF1, tw, ht);
    else { fft_fwd(buf, logN, tw, ht);
#pragma unroll 2
        for (int i = ht; i < N; i += 256) buf[PHYS(i)] = cmul(buf[PHYS(i)], KF1[i]);
        fft_inv(buf, logN, tw, ht); }
#pragma unroll 1
    for (int t8 = ht * 8; t8 < L; t8 += 2048) { float xa[8], xb[8];
        unpack8(*(const u32x4*)(v0 + (size_t)1024 * L + t8), xa); unpack8(*(const u32x4*)(v1 + (size_t)1024 * L + t8), xb);
        const float4 p0 = *(const float4*)(y0 + t8), p1 = *(const float4*)(y0 + t8 + 4), q0 = *(const float4*)(y1 + t8), q1 = *(const float4*)(y1 + t8 + 4);
        const float za[8] = {p0.x, p0.y, p0.z, p0.w, p1.x, p1.y, p1.z, p1.w}, zb[8] = {q0.x, q0.y, q0.z, q0.w, q1.x, q1.y, q1.z, q1.w};
        float oa[8], ob[8];
#pragma unroll
        for (int j = 0; j < 8; ++j) { const c2 cv = buf[PHYS(t8 + j)]; oa[j] = xa[j] * (cv.x + bias1 * za[j]); ob[j] = xb[j] * (cv.y + bias1 * zb[j]); }
        *(float4*)(y0 + t8) = make_float4(oa[0], oa[1], oa[2], oa[3]); *(float4*)(y0 + t8 + 4) = make_float4(oa[4], oa[5], oa[6], oa[7]);
        *(float4*)(y1 + t8) = make_float4(ob[0], ob[1], ob[2], ob[3]); *(float4*)(y1 + t8 + 4) = make_float4(ob[4], ob[5], ob[6], ob[7]); }
    __syncthreads();
}

__device__ __forceinline__ void phase_m2(PRef p, int layer, unsigned char* shm, bool scans) {
    const int gid = blockIdx.x * 512 + otid(), gsz = scans ? gridDim.x * 512 : 0x40000000;
#if EN_RET
    for (int ch = scans ? gid : 0x7fffffff - gsz; ch < 64 * 8192; ch += gsz) { const int bhd = ch >> 13, el = ch & 8191, dir = bhd & 1, h = (bhd >> 1) & 7;
        const float dec = expf(-128.f * expf(p.in[17][(layer * 2 + dir) * 8 + h]));
        float* base = (float*)(p.ws + O_RETST) + (size_t)bhd * 34 * 8192 + el;
        float inc[34];
#pragma unroll
        for (int sidx = 0; sidx < 34; ++sidx) { const int cidx = dir == 0 ? sidx : (sidx < 2 ? 1 - sidx : 35 - sidx); inc[sidx] = base[(size_t)cidx * 8192]; }
        float st = 0.f;
#pragma unroll
        for (int sidx = 0; sidx < 34; ++sidx) { const int cidx = dir == 0 ? sidx : (sidx < 2 ? 1 - sidx : 35 - sidx);
            base[(size_t)cidx * 8192] = st; st = dec * st + inc[sidx]; } }
#endif
#if EN_S5
    for (int ch = scans ? gid : 0x7fffffff - gsz; ch < 256 * 64; ch += gsz) { const int gdb = ch >> 6, pp = ch & 63, g = gdb >> 3, dir = (gdb >> 2) & 1;
        const c2 lt = ((const c2*)(p.ws + O_S5LT))[(dir * 32 + g) * 64 + pp];
        c2* base = (c2*)((float*)(p.ws + O_S5ST) + (size_t)gdb * 68 * 128) + pp;
        c2 st = mkc2(0.f, 0.f);
#pragma unroll 1
        for (int half = 0; half < 2; ++half) {
            c2 inc[34];
#pragma unroll
            for (int j = 0; j < 34; ++j) { const int sidx = half * 34 + j; const int cidx = dir == 0 ? sidx : (sidx < 4 ? 3 - sidx : 71 - sidx); inc[j] = base[(size_t)cidx * 64]; }
#pragma unroll
            for (int j = 0; j < 34; ++j) { const int sidx = half * 34 + j; const int cidx = dir == 0 ? sidx : (sidx < 4 ? 3 - sidx : 71 - sidx);
                base[(size_t)cidx * 64] = st; const c2 ns = cmul(lt, st); st = mkc2(ns.x + inc[j].x, ns.y + inc[j].y); } } }
#endif
#if EN_HY
    const int total = (layer == 0) ? 1024 : 512;
    for (int it = blockIdx.x; it < total; it += gridDim.x) { if (it < 512) hyconv_item<false>(p, layer, it, shm); else hyconv_item<true>(p, layer, it - 512, shm); }
#endif
}

__device__ __forceinline__ bf16x8 scale8(bf16x8 q, float s) {
    const u32x4 w = un8(q); u32x4 o;
    o.x = cvt_pk_bf16(bflo(w.x) * s, bfhi(w.x) * s); o.y = cvt_pk_bf16(bflo(w.y) * s, bfhi(w.y) * s);
    o.z = cvt_pk_bf16(bflo(w.z) * s, bfhi(w.z) * s); o.w = cvt_pk_bf16(bflo(w.w) * s, bfhi(w.w) * s);
    return mk8(o);
}
__device__ __forceinline__ void retout_item(PRef p, int layer, int item, unsigned char* shm) {
    const int tid = otid(), lane = tid & 63, wave = tid >> 6, fr = lane & 15, fq = lane >> 4;
    int b, h, n, row0, cidx;
    if (item < 1024) { b = item >> 8; h = (item >> 5) & 7; n = item & 31; row0 = b * 4096 + n * 128; cidx = 2 + n; }
    else { const int q = item - 1024; b = q >> 4; h = (q >> 1) & 7; n = q & 1; row0 = RL + b * 256 + n * 128; cidx = n; }
    const float lgf = -expf(p.in[17][(layer * 2 + 0) * 8 + h]), lgb = -expf(p.in[17][(layer * 2 + 1) * 8 + h]);
    const bf16_t* A = (const bf16_t*)(p.ws + O_A);
    bf16_t* MIX = (bf16_t*)(p.ws + O_XN);
    bf16_t* vT = (bf16_t*)shm;
    bf16_t* sTf = vT + 128 * LDK;
    bf16_t* sTb = sTf + 128 * 72;
    bf16_t* Pw = sTb + 128 * 72 + wave * 16 * LDK;
#pragma unroll
    for (int i = 0; i < 4; ++i) { const int idx = tid + 512 * i, m = idx >> 4, e8 = (idx & 15) * 8;
        const u32x4 v = *(const u32x4*)(A + (size_t)(row0 + m) * NIN + C_V + h * 128 + e8);
        const unsigned ww[4] = {v.x, v.y, v.z, v.w};
#pragma unroll
        for (int j = 0; j < 4; ++j) { vT[(e8 + 2 * j) * LDK + m] = (bf16_t)(ww[j] & 0xffffu); vT[(e8 + 2 * j + 1) * LDK + m] = (bf16_t)(ww[j] >> 16); } }
    { const float* SF = (const float*)(p.ws + O_RETST) + ((size_t)((b * 8 + h) * 2 + 0) * 34 + cidx) * 8192;
      const float* SB = (const float*)(p.ws + O_RETST) + ((size_t)((b * 8 + h) * 2 + 1) * 34 + cidx) * 8192;
#pragma unroll 4
      for (int i = 0; i < 16; ++i) { const int idx = tid + 512 * i, d = idx >> 7, e = idx & 127;
          sTf[e * 72 + d] = f2bf(SF[idx]); sTb[e * 72 + d] = f2bf(SB[idx]); } }
    __syncthreads();
    bf16x8 qa[2];
#pragma unroll
    for (int kk = 0; kk < 2; ++kk) qa[kk] = *(const bf16x8*)(A + (size_t)(row0 + 16 * wave + fr) * NIN + C_Q + h * 64 + kk * 32 + fq * 8);
#pragma unroll
    for (int nt = 0; nt < 8; ++nt) { f32x4 s = (f32x4){0.f, 0.f, 0.f, 0.f};
#pragma unroll
        for (int kk = 0; kk < 2; ++kk) { const bf16x8 kb = *(const bf16x8*)(A + (size_t)(row0 + 16 * nt + fr) * NIN + C_K + h * 64 + kk * 32 + fq * 8);
            s = __builtin_amdgcn_mfma_f32_16x16x32_bf16(qa[kk], kb, s, 0, 0, 0); }
        const int m = 16 * nt + fr;
#pragma unroll
        for (int r = 0; r < 4; ++r) { const int c = 16 * wave + fq * 4 + r; const float dd = (float)(c - m);
            const float dec = (m <= c) ? expf(dd * lgf) : expf(-dd * lgb);
            Pw[(fq * 4 + r) * LDK + m] = f2bf(s[r] * 0.125f * dec); } }
    __syncthreads();
    f32x4 acc[8];
#pragma unroll
    for (int et = 0; et < 8; ++et) acc[et] = (f32x4){0.f, 0.f, 0.f, 0.f};
#pragma unroll
    for (int kk = 0; kk < 4; ++kk) { const bf16x8 af = *(const bf16x8*)(Pw + fr * LDK + kk * 32 + fq * 8);
#pragma unroll
        for (int et = 0; et < 8; ++et) { const bf16x8 bf = *(const bf16x8*)(vT + (16 * et + fr) * LDK + kk * 32 + fq * 8);
            acc[et] = __builtin_amdgcn_mfma_f32_16x16x32_bf16(af, bf, acc[et], 0, 0, 0); } }
    { const int ca = 16 * wave + fr;
      const float sf = expf((float)(ca + 1) * lgf), sb = expf((float)(128 - ca) * lgb);
#pragma unroll
      for (int kk = 0; kk < 2; ++kk) { const bf16x8 af = scale8(qa[kk], sf), ab = scale8(qa[kk], sb);
#pragma unroll
          for (int et = 0; et < 8; ++et) { const bf16x8 b1 = *(const bf16x8*)(sTf + (16 * et + fr) * 72 + kk * 32 + fq * 8);
              acc[et] = __builtin_amdgcn_mfma_f32_16x16x32_bf16(af, b1, acc[et], 0, 0, 0);
              const bf16x8 b2 = *(const bf16x8*)(sTb + (16 * et + fr) * 72 + kk * 32 + fq * 8);
              acc[et] = __builtin_amdgcn_mfma_f32_16x16x32_bf16(ab, b2, acc[et], 0, 0, 0); } } }
#pragma unroll
    for (int r = 0; r < 4; ++r) { float ss = 0.f;
#pragma unroll
        for (int et = 0; et < 8; ++et) ss += acc[et][r] * acc[et][r];
        ss += __shfl_xor(ss, 1); ss += __shfl_xor(ss, 2); ss += __shfl_xor(ss, 4); ss += __shfl_xor(ss, 8);
        const float rinv = rsqrtf(ss * (1.f / 128.f) + 1e-6f);
        const size_t row = (size_t)(row0 + 16 * wave + fq * 4 + r);
#pragma unroll
        for (int et = 0; et < 8; ++et) { const int e = 16 * et + fr; const float gg = bf2f(A[row * NIN + C_G + h * 128 + e]);
            MIX[row * 2048 + 512 + h * 128 + e] = f2bf(acc[et][r] * rinv * gg * sigmoidf_(gg)); } }
    __syncthreads();
}

__device__ __forceinline__ void s5out_item(PRef p, int layer, int item, unsigned char* shm) {
    const int tid = otid(), lane = tid & 63, wave = tid >> 6, fr = lane & 15, fq = lane >> 4;
    const int g = item >> 3, b = (item >> 1) & 3, mh = item & 1;
    const bf16_t* A = (const bf16_t*)(p.ws + O_A);
    bf16_t* KT = (bf16_t*)shm;
    unsigned char* ul = shm + 65024;
    __syncthreads();
    { const u32x4* src = (const u32x4*)((const bf16_t*)(p.ws + O_S5K) + (size_t)g * 127 * 256); u32x4* dst = (u32x4*)shm;
      for (int i = tid; i < 127 * 256 / 8; i += 512) dst[i] = src[i]; }
    const int tb = 32 * mh + 4 * wave;
    bf16_t* Z = (bf16_t*)(p.ws + O_Z5);
    const f32x4 dv = *(const f32x4*)(p.in[25] + layer * 512 + g * 16 + fq * 4);
#pragma unroll 1
    for (int nt = 0; nt < (layer == 1 ? 4 : 5); ++nt) {
        __syncthreads();
        s5_stage_u(A, ul, b, g, nt, tid);
        __syncthreads();
        f32x4 acc[4];
#pragma unroll
        for (int mi = 0; mi < 4; ++mi) acc[mi] = (f32x4){0.f, 0.f, 0.f, 0.f};
#pragma unroll 4
        for (int kk = 0; kk < 32; ++kk) {
            const bf16x8 bfr = *(const bf16x8*)(ul + fr * S5_UP + kk * 64 + fq * 16);
            const int sq = 2 * kk + (fq >> 1);
#pragma unroll
            for (int mi = 0; mi < 4; ++mi) { const bf16x8 af = *(const bf16x8*)(KT + (tb + mi - sq + 63) * 256 + fr * 16 + (fq & 1) * 8);
                acc[mi] = __builtin_amdgcn_mfma_f32_16x16x32_bf16(af, bfr, acc[mi], 0, 0, 0); } }
        const int cidx = nt < 4 ? 4 + 16 * nt + fr : (fr & 3);
#pragma unroll
        for (int dir = 0; dir < 2; ++dir) {
            const bf16_t* G = (const bf16_t*)(p.ws + O_S5G) + (size_t)(dir * 32 + g) * 1024 * 128;
            const float* ST = (const float*)(p.ws + O_S5ST) + (size_t)((g * 2 + dir) * 4 + b) * 68 * 128 + (size_t)cidx * 128;
#pragma unroll
            for (int kk = 0; kk < 4; ++kk) {
                const f32x4 x0 = *(const f32x4*)(ST + kk * 32 + fq * 8), x1 = *(const f32x4*)(ST + kk * 32 + fq * 8 + 4);
                u32x4 w; w.x = cvt_pk_bf16(x0[0], x0[1]); w.y = cvt_pk_bf16(x0[2], x0[3]); w.z = cvt_pk_bf16(x1[0], x1[1]); w.w = cvt_pk_bf16(x1[2], x1[3]);
                const bf16x8 bfr = mk8(w);
#pragma unroll
                for (int mi = 0; mi < 4; ++mi) { const bf16x8 af = *(const bf16x8*)(G + (size_t)((tb + mi) * 16 + fr) * 128 + kk * 32 + fq * 8);
                    acc[mi] = __builtin_amdgcn_mfma_f32_16x16x32_bf16(af, bfr, acc[mi], 0, 0, 0); } } }
        if (nt < 4 || fr < 4) {
#pragma unroll
            for (int mi = 0; mi < 4; ++mi) { const int t = tb + mi; const size_t row = nt < 4 ? (size_t)(b * 4096 + (16 * nt + fr) * 64 + t) : (size_t)(RL + b * 256 + fr * 64 + t);
                const u32x2 uu = *(const u32x2*)(ul + fr * S5_UP + t * 32 + fq * 8);
                const f32x4 y = acc[mi];
                u32x2 w; w.x = cvt_pk_bf16(gelu_tanh(y[0] + dv[0] * bflo(uu.x)), gelu_tanh(y[1] + dv[1] * bfhi(uu.x)));
                w.y = cvt_pk_bf16(gelu_tanh(y[2] + dv[2] * bflo(uu.y)), gelu_tanh(y[3] + dv[3] * bfhi(uu.y)));
                *(u32x2*)(Z + row * 512 + g * 16 + fq * 4) = w; } }
    }
    __syncthreads();
}

__device__ __forceinline__ void hyback_witem(PRef p, bool isctx, int tile, unsigned char* shm, int wave, int lane) {
    const int L = isctx ? 256 : 4096, ntt = L / 32;
    const int b = tile / (ntt * 16), rem = tile % (ntt * 16), t0 = (rem / 16) * 32, c0 = (rem % 16) * 32;
    const float* Y = isctx ? (const float*)(p.ws + O_HYYC) : (const float*)(p.ws + O_HYY);
    bf16_t* MIX = (bf16_t*)(p.ws + O_XN) + (size_t)(isctx ? RL + b * 256 : b * 4096) * 2048;
    float* T = (float*)shm + wave * (32 * 33);
    { const int cl = lane >> 1, t16 = (lane & 1) * 16; const float4* sp = (const float4*)(Y + (size_t)(b * 512 + c0 + cl) * L + t0 + t16);
      float* d = T + cl * 33 + t16;
#pragma unroll
      for (int q = 0; q < 4; ++q) { const float4 a = sp[q]; d[4 * q] = a.x; d[4 * q + 1] = a.y; d[4 * q + 2] = a.z; d[4 * q + 3] = a.w; } }
    wave_sync_lds();
    { const int tl = lane >> 1, c16 = (lane & 1) * 16; const float* sp = T + c16 * 33 + tl;
      u32x4 wa, wb;
      wa.x = cvt_pk_bf16(sp[0], sp[33]); wa.y = cvt_pk_bf16(sp[2 * 33], sp[3 * 33]); wa.z = cvt_pk_bf16(sp[4 * 33], sp[5 * 33]); wa.w = cvt_pk_bf16(sp[6 * 33], sp[7 * 33]);
      wb.x = cvt_pk_bf16(sp[8 * 33], sp[9 * 33]); wb.y = cvt_pk_bf16(sp[10 * 33], sp[11 * 33]); wb.z = cvt_pk_bf16(sp[12 * 33], sp[13 * 33]); wb.w = cvt_pk_bf16(sp[14 * 33], sp[15 * 33]);
      bf16_t* dst = MIX + (size_t)(t0 + tl) * 2048 + c0 + c16;
      *(u32x4*)dst = wa; *(u32x4*)(dst + 8) = wb; }
    wave_sync_lds();
}

__device__ __forceinline__ void zero_mix_cols(PRef p, int col0, int ncols) {
    bf16_t* MIX = (bf16_t*)(p.ws + O_XN);
    for (size_t i = (size_t)blockIdx.x * 512 + otid(); i < (size_t)RT * ncols; i += (size_t)gridDim.x * 512) MIX[(i / ncols) * 2048 + col0 + (i % ncols)] = 0;
}

__device__ __forceinline__ void phase_m3(PRef p, int layer, unsigned char* shm) {
    constexpr int N_S5O = 256;
    const int N_RO = layer == 1 ? 1024 : 1088;
    for (int it = blockIdx.x; it < N_S5O + N_RO; it += gridDim.x) {
        int r = it;
        if (r < N_S5O) {
#if EN_S5
            for (int rep = 0; rep < NREP(8); ++rep) s5out_item(p, layer, r, shm);
#endif
            continue; }
        r -= N_S5O;
#if EN_RET
        for (int rep = 0; rep < NREP(9); ++rep) retout_item(p, layer, r, shm);
#endif
    }
    __syncthreads();
#if EN_HY
    const int n_hyb = (layer == 0) ? 8192 + 512 : 8192;
    const int tid = otid(), wave = tid >> 6, lane = tid & 63;
    for (int it = blockIdx.x * 8 + wave; it < n_hyb; it += gridDim.x * 8)
        for (int rep = 0; rep < NREP(10); ++rep) { if (it < 8192) hyback_witem(p, false, it, shm, wave, lane); else hyback_witem(p, true, it - 8192, shm, wave, lane); }
#else
    zero_mix_cols(p, 0, 512);
#endif
#if !EN_RET
    zero_mix_cols(p, 512, 1024);
#endif
#if !EN_S5
    zero_mix_cols(p, 1536, 512);
#endif
}

__device__ __forceinline__ void phase_conv(PRef p, int layer, int nseg) {
    const int tid = otid(), fg = tid & 63, xs = tid >> 6;
    bf16_t* GV = (bf16_t*)(p.ws + O_GV);
    const float* CW = p.in[31] + (size_t)layer * 9 * NFF; const float* CB = p.in[32] + (size_t)layer * NFF;
    for (int it = blockIdx.x; it < nseg * 11; it += gridDim.x) {
        const int seg = it / 11, f = (it % 11) * 512 + fg * 8;
        const bool isc = seg >= 256;
        float w[9][8], bias[8];
#pragma unroll
        for (int k = 0; k < 9; ++k) { const float4 a = *(const float4*)(CW + (size_t)k * NFF + f), bq = *(const float4*)(CW + (size_t)k * NFF + f + 4);
            w[k][0] = a.x; w[k][1] = a.y; w[k][2] = a.z; w[k][3] = a.w; w[k][4] = bq.x; w[k][5] = bq.y; w[k][6] = bq.z; w[k][7] = bq.w; }
        { const float4 a = *(const float4*)(CB + f), bq = *(const float4*)(CB + f + 4); bias[0] = a.x; bias[1] = a.y; bias[2] = a.z; bias[3] = a.w; bias[4] = bq.x; bias[5] = bq.y; bias[6] = bq.z; bias[7] = bq.w; }
        int W, x0; const bf16_t* lp[3]; bool lv[3];
        if (!isc) { const int b = seg >> 6, r = seg & 63; W = 64; x0 = 8 * xs;
#pragma unroll
            for (int ky = 0; ky < 3; ++ky) { const int yy = r + ky - 1; lv[ky] = (yy >= 0) && (yy < 64); lp[ky] = GV + ((size_t)b * 4096 + (size_t)(lv[ky] ? yy : r) * 64) * NUP + f; } }
        else { const int s2 = seg - 256, b = s2 >> 2, q = s2 & 3; W = 256; x0 = q * 64 + 8 * xs;
#pragma unroll
            for (int ky = 0; ky < 3; ++ky) { lv[ky] = (ky == 1); lp[ky] = GV + ((size_t)RL + b * 256) * NUP + f; } }
#pragma unroll 1
        for (int hx = 0; hx < 2; ++hx) { const int xb = x0 + 4 * hx;
            u32x4 gc[3][6], vv[4];
#pragma unroll
            for (int ky = 0; ky < 3; ++ky)
#pragma unroll
                for (int cx = 0; cx < 6; ++cx) { const int xx = xb - 1 + cx;
                    gc[ky][cx] = (lv[ky] && xx >= 0 && xx < W) ? *(const u32x4*)(lp[ky] + (size_t)xx * NUP) : (u32x4){0u, 0u, 0u, 0u}; }
#pragma unroll
            for (int xi = 0; xi < 4; ++xi) vv[xi] = *(const u32x4*)(lp[1] + (size_t)(xb + xi) * NUP + NFF);
#pragma unroll
            for (int xi = 0; xi < 4; ++xi) {
                float acc[8];
#pragma unroll
                for (int j = 0; j < 8; ++j) acc[j] = bias[j];
#pragma unroll
                for (int ky = 0; ky < 3; ++ky)
#pragma unroll
                    for (int kx = 0; kx < 3; ++kx) { const u32x4 gq = gc[ky][xi + kx]; const int k = ky * 3 + kx;
                        acc[0] += w[k][0] * bflo(gq.x); acc[1] += w[k][1] * bfhi(gq.x); acc[2] += w[k][2] * bflo(gq.y); acc[3] += w[k][3] * bfhi(gq.y);
                        acc[4] += w[k][4] * bflo(gq.z); acc[5] += w[k][5] * bfhi(gq.z); acc[6] += w[k][6] * bflo(gq.w); acc[7] += w[k][7] * bfhi(gq.w); }
                u32x4 o;
                o.x = cvt_pk_bf16(gelu_tanh(acc[0]) * bflo(vv[xi].x), gelu_tanh(acc[1]) * bfhi(vv[xi].x));
                o.y = cvt_pk_bf16(gelu_tanh(acc[2]) * bflo(vv[xi].y), gelu_tanh(acc[3]) * bfhi(vv[xi].y));
                o.z = cvt_pk_bf16(gelu_tanh(acc[4]) * bflo(vv[xi].z), gelu_tanh(acc[5]) * bfhi(vv[xi].z));
                o.w = cvt_pk_bf16(gelu_tanh(acc[6]) * bflo(vv[xi].w), gelu_tanh(acc[7]) * bfhi(vv[xi].w));
                *(u32x4*)((bf16_t*)lp[1] + (size_t)(xb + xi) * NUP + NFF) = o; } }
    }
}

__device__ __forceinline__ void final_norm_phase(const float* h, const float* g, float* out) {
    const int lane = otid() & 63, gw = blockIdx.x * 8 + (otid() >> 6), ngw = gridDim.x * 8;
    for (int row = gw; row < RL; row += ngw) {
        const float4* xr = (const float4*)(h + (size_t)row * D) + lane;
        float4 v[8]; float s = 0.f;
#pragma unroll
        for (int j = 0; j < 8; ++j) { v[j] = xr[64 * j]; s += v[j].x * v[j].x + v[j].y * v[j].y + v[j].z * v[j].z + v[j].w * v[j].w; }
        const float r = rsqrtf(wave_sum(s) * (1.f / D) + 1e-6f);
        float4* o = (float4*)(out + (size_t)row * D) + lane;
#pragma unroll
        for (int j = 0; j < 8; ++j) { const float4 gg = ((const float4*)g)[lane + 64 * j]; float4 w; w.x = v[j].x * r * gg.x; w.y = v[j].y * r * gg.y; w.z = v[j].z * r * gg.z; w.w = v[j].w * r * gg.w; o[64 * j] = w; }
    }
}

__device__ __forceinline__ void gbar(unsigned char* ws, unsigned k) {
    unsigned* base = (unsigned*)(ws + O_BAR);
    asm volatile("s_waitcnt vmcnt(0) lgkmcnt(0)" ::: "memory");
    __syncthreads();
    if (otid() == 0) {
        const unsigned g = blockIdx.x & 15u, ng = gridDim.x >> 4;
        __builtin_amdgcn_fence(__ATOMIC_RELEASE, "agent");
        const unsigned old = __hip_atomic_fetch_add(base + g * 32, 1u, __ATOMIC_RELAXED, __HIP_MEMORY_SCOPE_AGENT);
        if (old + 1u == k * ng) {
            const unsigned ot = __hip_atomic_fetch_add(base + 1024, 1u, __ATOMIC_RELAXED, __HIP_MEMORY_SCOPE_AGENT);
            if (ot + 1u == k * 16u) { for (unsigned gg = 0; gg < 16u; ++gg) __hip_atomic_store(base + 512 + gg * 32, k, __ATOMIC_RELAXED, __HIP_MEMORY_SCOPE_AGENT); }
        }
        while (__hip_atomic_load(base + 512 + g * 32, __ATOMIC_RELAXED, __HIP_MEMORY_SCOPE_AGENT) < k) __builtin_amdgcn_s_sleep(1);
        __builtin_amdgcn_fence(__ATOMIC_ACQUIRE, "agent");
    }
    __syncthreads();
}
__global__ void __launch_bounds__(512, 2) fwd_megakernel(Params p_) {
    extern __shared__ __attribute__((aligned(16))) unsigned char shm[];
    cg::grid_group grid = cg::this_grid();
    LAS unsigned char* lds = (LAS unsigned char*)shm;
#define mod ((const float*)(getp().ws + O_MOD))
#define hctx ((float*)(getp().ws + O_HCTX))
#define XN ((bf16_t*)(getp().ws + O_XN))
#define Abuf ((bf16_t*)(getp().ws + O_A))
#define GV ((bf16_t*)(getp().ws + O_GV))
    pg8::StaticOrder S;
    unsigned bar_n = 0;
#define GBAR() do { bar_n += 1u; gbar(getp().ws, bar_n); } while (0)
    { const int tid = otid();
      if (tid < 128) { const int e = tid < 64 ? tid << 6 : tid - 64; float sn, cs; sincospif((float)e * (1.f / 4096.f), &sn, &cs); ((LAS c2*)(shm + SCR_OFF + SCR_TW))[tid] = mkc2(cs, -sn); }
      __syncthreads(); }

    for (int rep = 0; rep < NREP(0); ++rep) { phase_p0(getp(), shm); grid.sync(); }
    for (int rep = 0; rep < ((REP_MASK >> 13) & 1) * 24; ++rep) GBAR();
#pragma unroll 2
    for (int layer = 0; layer < 2; ++layer) {
        const bool last = layer == 1;
#define hL (layer == 0 ? getp().in[0] : (const float*)getp().out)
#define hC (layer == 0 ? getp().in[2] : (const float*)hctx)
        const int Mrest = last ? RL : RT;
        for (int rep = 0; rep < NREP(1); ++rep) { phase_lprep(getp(), layer, shm, hL, hC); GBAR(); }
        { pg8::Gemm g{XN, (const bf16_t*)(getp().ws + O_WT_IN), RT, NIN, 2048, 2048, 2048}; S.init(g.M, g.N, gridDim.x, blockIdx.x);
          EpiStoreBf16 E{Abuf, NIN}; GEMM_REP(pg8::gemm_phase(lds, g, S, E); GBAR();) }
        for (int rep = 0; rep < NREP(3); ++rep) { phase_m1(getp(), layer, shm); GBAR(); }
        phase_m2(getp(), layer, shm, true);
        GBAR();
        for (int rep = 1; rep < NREP(4); ++rep) { phase_m2(getp(), layer, shm, false); GBAR(); }
        for (int rep = 0; rep < NREP(5); ++rep) { phase_m3(getp(), layer, shm); GBAR(); }
        { pg8::Gemm g{(const bf16_t*)(getp().ws + O_Z5), (const bf16_t*)(getp().ws + O_WT_GLU), RT, 512, 512, 512, 512}; S.init(g.M, g.N, gridDim.x, blockIdx.x);
          EpiGlu E{(const bf16_t*)(getp().ws + O_Z5), XN, getp().in[27] + layer * 512};
          GEMM_REP(pg8::gemm_phase(lds, g, S, E); GBAR();)
        }
        { pg8::Gemm g{XN, (const bf16_t*)(getp().ws + O_WT_OUT), RL, 2048, 2048, 2048, 2048}; S.init(g.M, g.N, gridDim.x, blockIdx.x);
          EpiResid E{hL, hC, getp().out, hctx, mod + (size_t)layer * 5 * 12288 + 2 * 2048}; pg8::gemm_phase(lds, g, S, E); }
        if (layer == 0) {
            for (int L2 = blockIdx.x; L2 < 256; L2 += gridDim.x) { const int part = L2 & 7, uu = L2 >> 3; pg8::SingleOrder S1{RL / 256 + (uu & 3), uu >> 2, true};
            pg8::Gemm g{XN + part * 256, (const bf16_t*)(getp().ws + O_WT_OUT) + part * 256, RT, 2048, 256, 2048, 2048};
            EpiResidAtomic E{hctx, mod + (size_t)(layer * 5 + 4) * 12288 + 2 * 2048}; pg8::gemm_phase(lds, g, S1, E); }
        }
        GBAR();
        { const int tid = otid(); for (int row = blockIdx.x * 8 + (tid >> 6); row < Mrest; row += gridDim.x * 8) xn_row1(getp(), layer, 1, row, tid & 63, getp().out, hctx); }
        GBAR();
        for (int rep = 1; rep < NREP(6); ++rep) { const int tid = otid(); for (int row = blockIdx.x * 8 + (tid >> 6); row < Mrest; row += gridDim.x * 8) xn_row1(getp(), layer, 1, row, tid & 63, getp().out, hctx); GBAR(); }
        { pg8::Gemm g{XN, (const bf16_t*)(getp().ws + O_WT_UP), Mrest, NUP, 2048, 2048, 2048}; S.init(g.M, g.N, gridDim.x, blockIdx.x);
          EpiStoreBf16 E{GV, NUP};
          pg8::gemm_phase(lds, g, S, E);
          GBAR(); }
        phase_conv(getp(), layer, last ? 256 : 272);
        GBAR();
        { pg8::Gemm g{GV + NFF, (const bf16_t*)(getp().ws + O_WT_DOWN), RL, 2048, NFF, NUP, NFF}; S.init(g.M, g.N, gridDim.x, blockIdx.x);
          EpiResid E{getp().out, hctx, getp().out, hctx, mod + (size_t)layer * 5 * 12288 + 5 * 2048}; pg8::gemm_phase(lds, g, S, E); }
        if (layer == 0) {
            for (int L2 = blockIdx.x; L2 < 128; L2 += gridDim.x) { const int part = L2 & 3, uu = L2 >> 2; pg8::SingleOrder S1{RL / 256 + (uu & 3), (uu >> 2) & 7, true};
            pg8::Gemm g{GV + NFF + part * 1408, (const bf16_t*)(getp().ws + O_WT_DOWN) + part * 1408, RT, 2048, 1408, NUP, NFF};
            EpiResidAtomic E{hctx, mod + (size_t)(layer * 5 + 4) * 12288 + 5 * 2048}; pg8::gemm_phase(lds, g, S1, E); }
        }
        GBAR();
    }
    final_norm_phase(getp().out, getp().in[34], getp().out);
}

extern "C" void kernel_launch(void* const* d_in, const int* in_sizes, int n_in, void* d_out, int out_size, void* d_ws, size_t ws_size, hipStream_t stream) {
    static int grid_blocks = 0;
    if (grid_blocks == 0) {
        int dev = 0, cus = 0, per_cu = 0;
        (void)hipGetDevice(&dev);
        (void)hipDeviceGetAttribute(&cus, hipDeviceAttributeMultiprocessorCount, dev);
        if (hipFuncSetAttribute((const void*)fwd_megakernel, hipFuncAttributeMaxDynamicSharedMemorySize, LDS_BYTES) != hipSuccess) fprintf(stderr, "hipFuncSetAttribute failed\n");
        (void)hipOccupancyMaxActiveBlocksPerMultiprocessor(&per_cu, (const void*)fwd_megakernel, 512, LDS_BYTES);
        (void)hipGetLastError();
        grid_blocks = cus & ~15;
        if (n_in != 35 || ws_size < O_END2) { fprintf(stderr, "kernel_launch: unexpected n_in %d or workspace %zu < %zu\n", n_in, ws_size, (size_t)O_END2); grid_blocks = -1; }
    }
    if (grid_blocks < 0) return;
    Params p{};
    for (int i = 0; i < 35; ++i) p.in[i] = (const float*)d_in[i];
    p.out = (float*)d_out; p.ws = (unsigned char*)d_ws; p.ws_size = (unsigned long long)ws_size;
    void* args[] = {&p};
    hipError_t e = hipLaunchCooperativeKernel((const void*)fwd_megakernel, dim3(grid_blocks), dim3(512), args, LDS_BYTES, stream);
    if (e != hipSuccess) fprintf(stderr, "cooperative launch failed: %s (grid %d)\n", hipGetErrorString(e), grid_blocks);
}
```

```cpp
#include <hip/hip_runtime.h>
#include <hip/hip_cooperative_groups.h>
#include <cstdio>
namespace cg = cooperative_groups;

#define LAS __attribute__((address_space(3)))
typedef unsigned short bf16_t;
typedef short bf16x8 __attribute__((ext_vector_type(8)));
typedef float f32x4 __attribute__((ext_vector_type(4)));
typedef unsigned u32x4 __attribute__((ext_vector_type(4)));
typedef unsigned u32x2 __attribute__((ext_vector_type(2)));
typedef float c2 __attribute__((ext_vector_type(2)));

#ifndef REP_MASK
#define REP_MASK 0
#endif
#define NREP(bit) ((REP_MASK >> (bit)) & 1 ? 2 : 1)
#if (REP_MASK >> 2) & 1
#define GEMM_REP(stmt) stmt stmt
#else
#define GEMM_REP(stmt) stmt
#endif
#ifndef EN_RET
#define EN_RET 1
#endif
#ifndef EN_S5
#define EN_S5 1
#endif
#ifndef EN_HY
#define EN_HY 1
#endif

struct Params {
    const float* in[35];
    float* out;
    unsigned char* ws;
    unsigned long long ws_size;
};

typedef const __attribute__((address_space(4))) Params& PRef;
__device__ __forceinline__ PRef getp() { const __attribute__((address_space(4))) Params* kp = (const __attribute__((address_space(4))) Params*)__builtin_amdgcn_kernarg_segment_ptr(); asm volatile("" : "+s"(kp)); return *kp; }
constexpr int D = 2048, NB = 4, SEQ = 4096, LC = 256, RL = NB * SEQ, RC = NB * LC, RT = RL + RC;
constexpr int NIN = 5120, NFF = 5632, NUP = 11264;
constexpr int C_Q = 1536, C_K = 2048, C_V = 2560, C_G = 3584, C_U = 4608;
constexpr int LDS_BYTES = 143360, SCR_OFF = 139264, SCR_WCOL = 64, SCR_TW = 1088, FFT_PAD = 8704;

constexpr size_t al256(size_t x) { return (x + 255) & ~(size_t)255; }
constexpr size_t O_WT_IN = 0;
constexpr size_t O_WT_OUT = O_WT_IN + (size_t)5120 * 2048 * 2;
constexpr size_t O_WT_UP = O_WT_OUT + (size_t)2048 * 2048 * 2;
constexpr size_t O_WT_DOWN = O_WT_UP + (size_t)11264 * 2048 * 2;
constexpr size_t O_WT_GLU = O_WT_DOWN + (size_t)2048 * 5632 * 2;
constexpr size_t O_HCTX = O_WT_GLU + (size_t)512 * 512 * 2;
constexpr size_t O_MOD = O_HCTX + (size_t)RC * 2048 * 4;
constexpr size_t O_HID = O_MOD + al256((size_t)2 * 5 * 12288 * 4);
constexpr size_t O_TW = O_HID + (size_t)2 * 4352 * 64 * 4;
constexpr size_t O_KF = O_TW + 4096 * 8;
constexpr size_t O_KFC = O_KF + (size_t)2 * 512 * 8192 * 8;
constexpr size_t O_S5E = O_KFC + (size_t)2 * 512 * 512 * 8;
constexpr size_t O_S5G = O_S5E + (size_t)64 * 128 * 1024 * 2;
constexpr size_t O_S5K = O_S5G + (size_t)64 * 1024 * 128 * 2;
constexpr size_t O_S5LT = O_S5K + al256((size_t)32 * 127 * 256 * 2);
constexpr size_t O_XN = O_S5LT + 64 * 64 * 8;
constexpr size_t O_U = O_XN + (size_t)RT * 2048 * 2;
constexpr size_t O_A = O_U;
constexpr size_t O_HYT = O_A + (size_t)RT * 5120 * 2;
constexpr size_t O_HYTC = O_HYT + (size_t)4 * 1536 * 4096 * 2;
constexpr size_t O_HYY = O_HYTC + (size_t)4 * 1536 * 256 * 2;
constexpr size_t O_HYYC = O_HYY + (size_t)4 * 512 * 4096 * 4;
constexpr size_t O_Z5 = O_HYYC + (size_t)4 * 512 * 256 * 4;
constexpr size_t O_RETST = O_Z5 + (size_t)RT * 512 * 2;
constexpr size_t O_S5ST = O_RETST + (size_t)64 * 34 * 8192 * 4;
constexpr size_t O_MIXEND = O_S5ST + (size_t)256 * 68 * 128 * 4;
constexpr size_t O_GV = O_U;
constexpr size_t O_END = O_GV + (size_t)RT * 11264 * 2;
static_assert(O_MIXEND <= O_END, "mixer buffers must fit in the union region");
constexpr size_t O_QCTR = O_END;
constexpr size_t O_BAR = O_QCTR + 256;
constexpr size_t O_END2 = O_BAR + 8192;

__device__ __forceinline__ int otid() { int t = (int)__builtin_amdgcn_workitem_id_x(); asm volatile("" : "+v"(t)); return t; }
__device__ __forceinline__ unsigned cvt_pk_bf16(float lo, float hi) { unsigned r; asm("v_cvt_pk_bf16_f32 %0, %1, %2" : "=v"(r) : "v"(lo), "v"(hi)); return r; }
__device__ __forceinline__ float bf2f(unsigned short b) { return __uint_as_float(((unsigned)b) << 16); }
__device__ __forceinline__ float bflo(unsigned w) { return __uint_as_float(w << 16); }
__device__ __forceinline__ float bfhi(unsigned w) { return __uint_as_float(w & 0xffff0000u); }
__device__ __forceinline__ unsigned short f2bf(float f) { return (unsigned short)(cvt_pk_bf16(f, 0.f) & 0xffffu); }
__device__ __forceinline__ float sigmoidf_(float x) { return 1.f / (1.f + __expf(-x)); }
__device__ __forceinline__ float gelu_tanh(float x) { const float u = 0.7978845608028654f * (x + 0.044715f * x * x * x); return x / (1.f + __expf(-2.f * u)); }
__device__ __forceinline__ float wave_sum(float v) {
#pragma unroll
    for (int o = 1; o < 64; o <<= 1) v += __shfl_xor(v, o);
    return v;
}
__device__ __forceinline__ c2 mkc2(float x, float y) { c2 r; r.x = x; r.y = y; return r; }
__device__ __forceinline__ c2 cmul(c2 a, c2 b) { return mkc2(a.x * b.x - a.y * b.y, a.x * b.y + a.y * b.x); }
__device__ __forceinline__ c2 cmulc(c2 a, c2 b) { return mkc2(a.x * b.x + a.y * b.y, a.y * b.x - a.x * b.y); }
__device__ __forceinline__ bf16x8 mk8(u32x4 w) { union { u32x4 u; bf16x8 b; } x; x.u = w; return x.b; }
__device__ __forceinline__ u32x4 un8(bf16x8 b) { union { u32x4 u; bf16x8 b; } x; x.b = b; return x.u; }

namespace pg8 {
constexpr int BM = 256, BK = 64, HALF = 128, HTB = HALF * BK * 2, STAGE_BYTES = 8 * HTB, NXCD = 8, WGM = 8;
__host__ __device__ __forceinline__ int lds_byte(int r, int c) { const int st = (r >> 4) * 2 + (c >> 5), rr = r & 15, cc = c & 31, ob = rr * 64 + cc * 2; return st * 1024 + (ob ^ (((ob >> 9) & 1) << 5)); }
__host__ __device__ __forceinline__ void stage_rc(int b, int& R, int& C) { const int st = b / 1024, sb = b % 1024, swz = sb ^ (((sb >> 9) & 1) << 5); R = (st >> 1) * 16 + swz / 64; C = (st & 1) * 32 + (swz % 64) / 2; }
__host__ __device__ __forceinline__ int perm32(int rho) { const int n = rho >> 4, i = rho & 15; return 8 * (i >> 2) + 4 * n + (i & 3); }
struct Unit { int pm, pn; };
struct Gemm { const bf16_t* A; const bf16_t* Bt; int M, N, K, lda, ldb; };
struct StaticOrder {
    int nM, nN, nwg, G, c;
    __device__ void init(int M, int N, int G_, int c_) { nM = M / BM; nN = N / BM; nwg = nM * nN; G = G_; c = c_; }
    __device__ bool next(int i, Unit& u) const {
        const long L = (long)i * G + c; if (L >= nwg) return false;
        int wgid = (int)L; { const int q = nwg / NXCD, r = nwg % NXCD, xcd = wgid % NXCD, off = wgid / NXCD; wgid = (xcd < r ? xcd * (q + 1) : r * (q + 1) + (xcd - r) * q) + off; }
        const int nig = WGM * nN, gid = wgid / nig, fm = gid * WGM, gsz = (nM - fm) < WGM ? (nM - fm) : WGM;
        u.pm = fm + ((wgid % nig) % gsz); u.pn = (wgid % nig) / gsz; return true;
    }
};

struct SingleOrder { int pm, pn; bool has; __device__ __forceinline__ bool next(int i, Unit& u) const { u.pm = pm; u.pn = pn; return has && i == 0; } };
template <class Epi, class Sched>
__device__ __forceinline__ void gemm_phase(LAS unsigned char* lds, const Gemm g, const Sched& S, const Epi& E) {
    const int tid = otid(), wid = __builtin_amdgcn_readfirstlane(tid >> 6), lane = tid & 63, wr = wid >> 2, wc = wid & 3, fr = lane & 15, fq = lane >> 4;
    const int K = g.K, nt = K / BK, lda = g.lda, ldb = g.ldb;
    unsigned voffA, voffB;
    { int R, C; stage_rc(tid * 16, R, C); const int Rb = Epi::PERM ? ((R & ~31) + perm32(R & 31)) : R;
      voffA = (unsigned)(R * lda + C) * 2u; voffB = (unsigned)(Rb * ldb + C) * 2u; }
    const size_t r64voffA = (size_t)64 * lda * 2, r64voffB = (size_t)64 * ldb * 2;
    const size_t kstep = (size_t)(BK * 2);
    const size_t hstepA = (size_t)HALF * lda * 2, hstepB = (size_t)HALF * ldb * 2;
    const size_t tstepA = 2 * hstepA, tstepB = 2 * hstepB;
    const unsigned ldsw = (unsigned)wid * 1024u;
    const int aoff = lds_byte(wr * 64 + fr, fq * 8), boff = lds_byte(wc * 32 + fr, fq * 8);
#define PG8_SA(b, h) (((b) * 2 + (h)) * HTB)
#define PG8_SB(b, h) ((4 + (b) * 2 + (h)) * HTB)
#define PG8_STAGE(bufoff, gbase, voff) do { _Pragma("unroll") for (int _i = 0; _i < 2; ++_i) \
        __builtin_amdgcn_global_load_lds((const unsigned*)((const char*)(gbase) + (size_t)_i * r64##voff + (voff)), (LAS unsigned*)(lds + (bufoff) + ldsw + _i * 8192), 16, 0, 0); } while (0)
#define PG8_LDA(dst, b, h) do { _Pragma("unroll") for (int m = 0; m < 4; ++m) _Pragma("unroll") for (int k = 0; k < 2; ++k) dst[m][k] = *(const LAS bf16x8*)(lds + PG8_SA(b, h) + aoff + m * 2048 + k * 1024); } while (0)
#define PG8_LDB(dst, b, h) do { _Pragma("unroll") for (int n = 0; n < 2; ++n) _Pragma("unroll") for (int k = 0; k < 2; ++k) dst[n][k] = *(const LAS bf16x8*)(lds + PG8_SB(b, h) + boff + n * 2048 + k * 1024); } while (0)
#define PG8_MMA(ai, bj, At, Bt) do { __builtin_amdgcn_s_setprio(1); _Pragma("unroll") for (int m = 0; m < 4; ++m) _Pragma("unroll") for (int n = 0; n < 2; ++n) _Pragma("unroll") for (int k = 0; k < 2; ++k) \
        acc[ai][bj][m][n] = __builtin_amdgcn_mfma_f32_16x16x32_bf16(Bt[n][k], At[m][k], acc[ai][bj][m][n], 0, 0, 0); __builtin_amdgcn_s_setprio(0); } while (0)
#define PG8_WAIT_V(n) asm volatile("s_waitcnt vmcnt(" #n ")" ::: "memory")
#define PG8_WAIT_L(n) asm volatile("s_waitcnt lgkmcnt(" #n ")" ::: "memory")
#define PG8_BAR __builtin_amdgcn_s_barrier()
#define PG8_SCHED __builtin_amdgcn_sched_barrier(0)
    Unit cur, nxt; int ui = 0;
    if (!S.next(0, cur)) return;
    f32x4 acc[2][2][4][2];
#pragma unroll
    for (int a = 0; a < 2; ++a)
#pragma unroll
        for (int b = 0; b < 2; ++b)
#pragma unroll
            for (int m = 0; m < 4; ++m)
#pragma unroll
                for (int n = 0; n < 2; ++n) acc[a][b][m][n] = (f32x4){0.f, 0.f, 0.f, 0.f};
    bf16x8 At[4][2], B0[2][2], B1[2][2];
    const char* cA = (const char*)g.A + (size_t)cur.pm * tstepA; const char* cB = (const char*)g.Bt + (size_t)cur.pn * tstepB;
    PG8_STAGE(PG8_SB(0, 0), cB, voffB); PG8_STAGE(PG8_SA(0, 0), cA, voffA); PG8_STAGE(PG8_SB(0, 1), cB + hstepB, voffB); PG8_STAGE(PG8_SA(0, 1), cA + hstepA, voffA);
    if (wr == 1) PG8_BAR;
    PG8_WAIT_V(4); PG8_BAR;
    PG8_STAGE(PG8_SB(1, 0), cB + kstep, voffB); PG8_STAGE(PG8_SA(1, 0), cA + kstep, voffA); PG8_STAGE(PG8_SB(1, 1), cB + hstepB + kstep, voffB);
    PG8_WAIT_V(6); PG8_BAR;
    for (;;) {
        const bool has_next = S.next(ui + 1, nxt);
        const char* nA = has_next ? (const char*)g.A + (size_t)nxt.pm * tstepA : cA; const char* nB = has_next ? (const char*)g.Bt + (size_t)nxt.pn * tstepB : cB;
        for (int t = 0; t < nt; t += 2) {
            const bool last = (t == nt - 2);
            const char* a1 = cA + (size_t)(t + 1) * kstep;
            const char* a2 = last ? nA : cA + (size_t)(t + 2) * kstep; const char* b2 = last ? nB : cB + (size_t)(t + 2) * kstep;
            const char* a3 = a2 + kstep; const char* b3 = b2 + kstep;
            PG8_LDB(B0, 0, 0); PG8_SCHED; PG8_LDA(At, 0, 0); PG8_STAGE(PG8_SA(1, 1), a1 + hstepA, voffA);
            PG8_WAIT_L(8); PG8_BAR; PG8_WAIT_L(0); PG8_MMA(0, 0, At, B0); PG8_BAR; PG8_SCHED;
            PG8_LDB(B1, 0, 1); PG8_STAGE(PG8_SB(0, 0), b2, voffB);
            PG8_BAR; PG8_WAIT_L(0); PG8_MMA(0, 1, At, B1); PG8_BAR;
            PG8_LDA(At, 0, 1); PG8_STAGE(PG8_SA(0, 0), a2, voffA);
            PG8_BAR; PG8_WAIT_L(0); PG8_MMA(1, 0, At, B0); PG8_BAR; PG8_SCHED;
            PG8_STAGE(PG8_SB(0, 1), b2 + hstepB, voffB);
            PG8_WAIT_V(6); PG8_BAR; PG8_MMA(1, 1, At, B1); PG8_BAR;
            PG8_LDB(B0, 1, 0); PG8_SCHED; PG8_LDA(At, 1, 0); PG8_STAGE(PG8_SA(0, 1), a2 + hstepA, voffA);
            PG8_WAIT_L(8); PG8_BAR; PG8_WAIT_L(0); PG8_MMA(0, 0, At, B0); PG8_BAR; PG8_SCHED;
            PG8_LDB(B1, 1, 1); PG8_STAGE(PG8_SB(1, 0), b3, voffB);
            PG8_BAR; PG8_WAIT_L(0); PG8_MMA(0, 1, At, B1); PG8_BAR;
            PG8_LDA(At, 1, 1); PG8_STAGE(PG8_SA(1, 0), a3, voffA);
            PG8_BAR; PG8_WAIT_L(0); PG8_MMA(1, 0, At, B0); PG8_BAR; PG8_SCHED;
            PG8_STAGE(PG8_SB(1, 1), b3 + hstepB, voffB);
            PG8_WAIT_V(6); PG8_BAR; PG8_MMA(1, 1, At, B1); PG8_BAR;
        }
        E(acc, cur, wr, wc, fr, fq);
        if (!has_next) break;
#pragma unroll
        for (int a = 0; a < 2; ++a)
#pragma unroll
            for (int b = 0; b < 2; ++b)
#pragma unroll
                for (int m = 0; m < 4; ++m)
#pragma unroll
                    for (int n = 0; n < 2; ++n) acc[a][b][m][n] = (f32x4){0.f, 0.f, 0.f, 0.f};
        cur = nxt; cA = nA; cB = nB; ++ui;
    }
    PG8_WAIT_V(0);
    if (wr == 0) PG8_BAR;
    PG8_BAR;
#undef PG8_SA
#undef PG8_SB
#undef PG8_STAGE
#undef PG8_LDA
#undef PG8_LDB
#undef PG8_MMA
#undef PG8_WAIT_V
#undef PG8_WAIT_L
#undef PG8_BAR
#undef PG8_SCHED
}
}

struct EpiStoreBf16 {
    static constexpr bool PERM = true;
    bf16_t* O; int ldc;
    __device__ __forceinline__ void operator()(const f32x4 (&acc)[2][2][4][2], const pg8::Unit& u, int wr_, int wc_, int fr_, int fq_) const {
        const int t2_ = otid(), wr = t2_ >> 8, wc = (t2_ >> 6) & 3, fr = t2_ & 15, fq = (t2_ >> 4) & 3; (void)wr_; (void)wc_; (void)fr_; (void)fq_;
        const int row0 = u.pm * 256 + wr * 64 + fr, col0 = u.pn * 256 + wc * 32 + 8 * fq;
#pragma unroll
        for (int ai = 0; ai < 2; ++ai)
#pragma unroll
            for (int m = 0; m < 4; ++m) { bf16_t* rowp = O + (size_t)(row0 + ai * 128 + m * 16) * ldc + col0;
#pragma unroll
                for (int bj = 0; bj < 2; ++bj) { const f32x4 v0 = acc[ai][bj][m][0], v1 = acc[ai][bj][m][1];
                    u32x4 w; w.x = cvt_pk_bf16(v0[0], v0[1]); w.y = cvt_pk_bf16(v0[2], v0[3]); w.z = cvt_pk_bf16(v1[0], v1[1]); w.w = cvt_pk_bf16(v1[2], v1[3]);
                    *(u32x4*)(rowp + bj * 128) = w; } }
    }
};
struct EpiGlu {
    static constexpr bool PERM = true;
    const bf16_t* Z; bf16_t* MIX; const float* bias;
    __device__ __forceinline__ void operator()(const f32x4 (&acc)[2][2][4][2], const pg8::Unit& u, int wr_, int wc_, int fr_, int fq_) const {
        const int t2_ = otid(), wr = t2_ >> 8, wc = (t2_ >> 6) & 3, fr = t2_ & 15, fq = (t2_ >> 4) & 3; (void)wr_; (void)wc_; (void)fr_; (void)fq_;
        const int row0 = u.pm * 256 + wr * 64 + fr, col0 = u.pn * 256 + wc * 32 + 8 * fq;
#pragma unroll
        for (int ai = 0; ai < 2; ++ai)
#pragma unroll
            for (int m = 0; m < 4; ++m) { const int row = row0 + ai * 128 + m * 16;
#pragma unroll
                for (int bj = 0; bj < 2; ++bj) { const int col = col0 + bj * 128;
                    const f32x4 b0 = *(const f32x4*)(bias + col), b1 = *(const f32x4*)(bias + col + 4);
                    const f32x4 v0 = acc[ai][bj][m][0] + b0, v1 = acc[ai][bj][m][1] + b1;
                    const u32x4 z = *(const u32x4*)(Z + (size_t)row * 512 + col);
                    u32x4 w;
                    w.x = cvt_pk_bf16(bflo(z.x) * sigmoidf_(v0[0]), bfhi(z.x) * sigmoidf_(v0[1]));
                    w.y = cvt_pk_bf16(bflo(z.y) * sigmoidf_(v0[2]), bfhi(z.y) * sigmoidf_(v0[3]));
                    w.z = cvt_pk_bf16(bflo(z.z) * sigmoidf_(v1[0]), bfhi(z.z) * sigmoidf_(v1[1]));
                    w.w = cvt_pk_bf16(bflo(z.w) * sigmoidf_(v1[2]), bfhi(z.w) * sigmoidf_(v1[3]));
                    *(u32x4*)(MIX + (size_t)row * 2048 + 1536 + col) = w; } }
    }
};
struct EpiResid {
    static constexpr bool PERM = false;
    const float* srcL; const float* srcC; float* dstL; float* dstC; const float* modsel;
    __device__ __forceinline__ void operator()(const f32x4 (&acc)[2][2][4][2], const pg8::Unit& u, int wr_, int wc_, int fr_, int fq_) const {
        const int t2_ = otid(), wr = t2_ >> 8, wc = (t2_ >> 6) & 3, fr = t2_ & 15, fq = (t2_ >> 4) & 3; (void)wr_; (void)wc_; (void)fr_; (void)fq_;
        const int rbase = u.pm * 256;
        const bool isc = rbase >= RL;
        const int mr = isc ? 4 : (rbase >> 12);
        const float* gate = modsel + (size_t)mr * 12288;
        const float* src = isc ? srcC - (size_t)RL * 2048 : srcL;
        float* dst = isc ? dstC - (size_t)RL * 2048 : dstL;
        const int row0 = rbase + wr * 64 + fr, col0 = u.pn * 256 + wc * 32 + 4 * fq;
#pragma unroll
        for (int ai = 0; ai < 2; ++ai)
#pragma unroll
            for (int m = 0; m < 4; ++m) { const size_t ro = (size_t)(row0 + ai * 128 + m * 16) * 2048;
#pragma unroll
                for (int bj = 0; bj < 2; ++bj)
#pragma unroll
                    for (int n = 0; n < 2; ++n) { const int col = col0 + bj * 128 + n * 16;
                        const f32x4 gg = *(const f32x4*)(gate + col), s = *(const f32x4*)(src + ro + col);
                        *(f32x4*)(dst + ro + col) = s + gg * acc[ai][bj][m][n]; } }
    }
};

struct EpiResidAtomic {
    static constexpr bool PERM = false;
    float* dstC; const float* gate;
    __device__ __forceinline__ void operator()(const f32x4 (&acc)[2][2][4][2], const pg8::Unit& u, int wr_, int wc_, int fr_, int fq_) const {
        const int t2_ = otid(), wr = t2_ >> 8, wc = (t2_ >> 6) & 3, fr = t2_ & 15, fq = (t2_ >> 4) & 3; (void)wr_; (void)wc_; (void)fr_; (void)fq_;
        float* dst = dstC - (size_t)RL * 2048;
        const int row0 = u.pm * 256 + wr * 64 + fr, col0 = u.pn * 256 + wc * 32 + 4 * fq;
#pragma unroll
        for (int ai = 0; ai < 2; ++ai)
#pragma unroll
            for (int m = 0; m < 4; ++m) { const size_t ro = (size_t)(row0 + ai * 128 + m * 16) * 2048;
#pragma unroll
                for (int bj = 0; bj < 2; ++bj)
#pragma unroll
                    for (int n = 0; n < 2; ++n) { const int col = col0 + bj * 128 + n * 16;
                        const f32x4 v = *(const f32x4*)(gate + col) * acc[ai][bj][m][n];
                        __hip_atomic_fetch_add(dst + ro + col, v[0], __ATOMIC_RELAXED, __HIP_MEMORY_SCOPE_AGENT); __hip_atomic_fetch_add(dst + ro + col + 1, v[1], __ATOMIC_RELAXED, __HIP_MEMORY_SCOPE_AGENT);
                        __hip_atomic_fetch_add(dst + ro + col + 2, v[2], __ATOMIC_RELAXED, __HIP_MEMORY_SCOPE_AGENT); __hip_atomic_fetch_add(dst + ro + col + 3, v[3], __ATOMIC_RELAXED, __HIP_MEMORY_SCOPE_AGENT); } }
    }
};

#define PHYS(i) ((i) + ((i) >> 4))
template <int R, bool INV>
__device__ __forceinline__ void fft_pass(LAS c2* buf, int logN, int s_lo, const LAS c2* twab, int ht) {
    const int N = 1 << logN, ngroups = N >> R, tshift = 13 - logN;
    constexpr int NE = 1 << R;
    constexpr float RH = 0.70710678118654752f;
#pragma unroll 2
    for (int q = ht; q < ngroups; q += 256) {
        const int qlo = q & (s_lo - 1), base = ((q - qlo) << R) + qlo;
        c2 x[NE];
#pragma unroll
        for (int k = 0; k < NE; ++k) x[k] = buf[PHYS(base + k * s_lo)];
#pragma unroll
        for (int u = 0; u < R; ++u) {
            const int h = INV ? (1 << u) : (1 << (R - 1 - u));
            const int e = (qlo * (N / (2 * h * s_lo))) << tshift;
            const c2 T = cmul(twab[e >> 6], twab[64 + (e & 63)]);
#pragma unroll
            for (int k = 0; k < NE; ++k) {
                if (k & h) continue;
                const int j8 = (k & (h - 1)) * (4 / h);
                const float cr = (j8 == 0) ? 1.f : (j8 == 1) ? RH : (j8 == 2) ? 0.f : -RH;
                const float ci = (j8 == 0) ? 0.f : (j8 == 1) ? -RH : (j8 == 2) ? -1.f : -RH;
                const c2 w = cmul(T, mkc2(cr, ci));
                if (!INV) { const c2 a = x[k], b = x[k + h]; x[k] = mkc2(a.x + b.x, a.y + b.y); x[k + h] = cmul(mkc2(a.x - b.x, a.y - b.y), w); }
                else { const c2 a = x[k], b = cmulc(x[k + h], w); x[k] = mkc2(a.x + b.x, a.y + b.y); x[k + h] = mkc2(a.x - b.x, a.y - b.y); }
            }
        }
#pragma unroll
        for (int k = 0; k < NE; ++k) buf[PHYS(base + k * s_lo)] = x[k];
    }
}
__device__ __forceinline__ void fft_fwd(LAS c2* buf, int logN, const LAS c2* tw, int ht) {
    __syncthreads();
    if (logN == 13) {
        fft_pass<3, false>(buf, 13, 1024, tw, ht); __syncthreads();
        fft_pass<3, false>(buf, 13, 128, tw, ht); __syncthreads();
        fft_pass<3, false>(buf, 13, 16, tw, ht); __syncthreads();
        fft_pass<3, false>(buf, 13, 2, tw, ht); __syncthreads();
        fft_pass<1, false>(buf, 13, 1, tw, ht); __syncthreads();
    } else {
        fft_pass<3, false>(buf, 9, 64, tw, ht); __syncthreads();
        fft_pass<3, false>(buf, 9, 8, tw, ht); __syncthreads();
        fft_pass<3, false>(buf, 9, 1, tw, ht); __syncthreads();
    }
}
__device__ __forceinline__ void fft_inv(LAS c2* buf, int logN, const LAS c2* tw, int ht) {
    __syncthreads();
    if (logN == 13) {
        fft_pass<1, true>(buf, 13, 1, tw, ht); __syncthreads();
        fft_pass<3, true>(buf, 13, 2, tw, ht); __syncthreads();
        fft_pass<3, true>(buf, 13, 16, tw, ht); __syncthreads();
        fft_pass<3, true>(buf, 13, 128, tw, ht); __syncthreads();
        fft_pass<3, true>(buf, 13, 1024, tw, ht); __syncthreads();
    } else {
        fft_pass<3, true>(buf, 9, 1, tw, ht); __syncthreads();
        fft_pass<3, true>(buf, 9, 8, tw, ht); __syncthreads();
        fft_pass<3, true>(buf, 9, 64, tw, ht); __syncthreads();
    }
}

__device__ __forceinline__ void fft_conv13(LAS c2* buf, const c2* __restrict__ KF, const LAS c2* tw, int ht) {
    __syncthreads();
    fft_pass<3, false>(buf, 13, 1024, tw, ht); __syncthreads();
    fft_pass<3, false>(buf, 13, 128, tw, ht); __syncthreads();
    fft_pass<3, false>(buf, 13, 16, tw, ht); __syncthreads();
    fft_pass<3, false>(buf, 13, 2, tw, ht); __syncthreads();
#pragma unroll 1
    for (int q = ht; q < 4096; q += 256) { const c2 x0 = buf[PHYS(2 * q)], x1 = buf[PHYS(2 * q + 1)]; const f32x4 kk = *(const f32x4*)(KF + 2 * q);
        const c2 a = cmul(mkc2(x0.x + x1.x, x0.y + x1.y), mkc2(kk[0], kk[1])), b = cmul(mkc2(x0.x - x1.x, x0.y - x1.y), mkc2(kk[2], kk[3]));
        buf[PHYS(2 * q)] = mkc2(a.x + b.x, a.y + b.y); buf[PHYS(2 * q + 1)] = mkc2(a.x - b.x, a.y - b.y); }
    __syncthreads();
    fft_pass<3, true>(buf, 13, 2, tw, ht); __syncthreads();
    fft_pass<3, true>(buf, 13, 16, tw, ht); __syncthreads();
    fft_pass<3, true>(buf, 13, 128, tw, ht); __syncthreads();
    fft_pass<3, true>(buf, 13, 1024, tw, ht); __syncthreads();
}

__device__ __forceinline__ void phase_p0(PRef p, unsigned char* shm) {
    const int tid = otid(), lane = tid & 63, wave = tid >> 6;
    float* mod = (float*)(p.ws + O_MOD); float* hid = (float*)(p.ws + O_HID);
    if (blockIdx.x == 0) for (int i = tid; i < 64 + 2048; i += 512) ((unsigned*)(p.ws + O_QCTR))[i] = 0u;
    { const float4* src = (const float4*)p.in[2]; float4* dst = (float4*)(p.ws + O_HCTX);
      for (int i = blockIdx.x * 512 + tid; i < RC * 2048 / 4; i += gridDim.x * 512) dst[i] = src[i]; }
    constexpr int N_MODIT = 768, N_HIDIT = 1088;
    float* sl = (float*)shm;
    float* part = sl + 5 * 2048;
    for (int it = blockIdx.x; it < N_MODIT + N_HIDIT; it += gridDim.x) {
        if (it < N_MODIT) {
            const int layer = it / 384, col0 = (it % 384) * 32;
#pragma unroll 10
            for (int i = tid; i < 5 * 2048; i += 512) { const int r = i >> 11, k = i & 2047; const float v = r < 4 ? p.in[1][r * 2048 + k] : p.in[3][k]; sl[i] = v * sigmoidf_(v); }
            __syncthreads();
            const int cl = tid & 31, kg = tid >> 5;
            const float* W = p.in[4] + ((size_t)layer * 2048 + kg * 128) * 12288 + col0 + cl;
            float a0 = 0.f, a1 = 0.f, a2 = 0.f, a3 = 0.f, a4 = 0.f;
#pragma unroll 16
            for (int k = 0; k < 128; ++k) { const float w = W[(size_t)k * 12288]; const int kk = kg * 128 + k;
                a0 += sl[kk] * w; a1 += sl[2048 + kk] * w; a2 += sl[4096 + kk] * w; a3 += sl[6144 + kk] * w; a4 += sl[8192 + kk] * w; }
            part[(kg * 5 + 0) * 32 + cl] = a0; part[(kg * 5 + 1) * 32 + cl] = a1; part[(kg * 5 + 2) * 32 + cl] = a2; part[(kg * 5 + 3) * 32 + cl] = a3; part[(kg * 5 + 4) * 32 + cl] = a4;
            __syncthreads();
            if (tid < 160) { const int r = tid >> 5, cc = tid & 31; float s = p.in[5][layer * 12288 + col0 + cc];
                for (int g = 0; g < 16; ++g) s += part[(g * 5 + r) * 32 + cc];
                mod[(size_t)(layer * 5 + r) * 12288 + col0 + cc] = s; }
            __syncthreads();
        } else {
            const int pi = (it - N_MODIT) * 8 + wave;
            const int layer = pi / 4352, q = pi % 4352;
            const int len = q < 4096 ? 4096 : 256, l = q < 4096 ? q : q - 4096;
            const float t = (float)l / (float)(len - 1);
            const float angb = (6.283185307179586f * (float)l) / (float)len;
            const float* w1 = p.in[10] + layer * 33 * 64; const float* w2 = p.in[12] + layer * 64 * 64;
            float pre = p.in[11][layer * 64 + lane] + t * w1[lane];
#pragma unroll 4
            for (int e = 0; e < 16; ++e) { const float band = 1e-4f + (float)e * ((15.f - 1e-4f) / 15.f); float s, c; sincosf(angb * band, &s, &c);
                pre += c * w1[(1 + e) * 64 + lane] - s * w1[(17 + e) * 64 + lane]; }
            const float h1 = sinf(p.in[15][(layer * 2 + 0) * 64 + lane] * pre);
            float* hb = (float*)shm + wave * 64;
            __syncthreads();
            hb[lane] = h1;
            __syncthreads();
            float pre2 = p.in[13][layer * 64 + lane];
#pragma unroll 16
            for (int i = 0; i < 64; ++i) pre2 += hb[i] * w2[i * 64 + lane];
            hid[(size_t)(layer * 4352 + q) * 64 + lane] = sinf(p.in[15][(layer * 2 + 1) * 64 + lane] * pre2);
            __syncthreads();
        }
    }
}

__device__ __forceinline__ void convT_tile(const float* __restrict__ W, int K, int N, bf16_t* __restrict__ WT, int tile, unsigned char* shm, int wave, int lane) {
    const int ntn = N / 64, k0 = (tile / ntn) * 64, n0 = (tile % ntn) * 64;
    float* T = (float*)shm + wave * (64 * 65);
    { const int r4 = lane >> 4, c4 = (lane & 15) * 4;
#pragma unroll
      for (int i = 0; i < 16; ++i) { const int rr = 4 * i + r4; const float4 v = *(const float4*)(W + (size_t)(k0 + rr) * N + n0 + c4);
          T[rr * 65 + c4] = v.x; T[rr * 65 + c4 + 1] = v.y; T[rr * 65 + c4 + 2] = v.z; T[rr * 65 + c4 + 3] = v.w; } }
    __builtin_amdgcn_fence(__ATOMIC_RELEASE, "wavefront"); __builtin_amdgcn_wave_barrier(); __builtin_amdgcn_fence(__ATOMIC_ACQUIRE, "wavefront");
    { const int n8 = lane >> 3, k8 = (lane & 7) * 8;
#pragma unroll
      for (int i = 0; i < 8; ++i) { const int n = 8 * i + n8; const float* sp = T + k8 * 65 + n;
          u32x4 o; o.x = cvt_pk_bf16(sp[0], sp[65]); o.y = cvt_pk_bf16(sp[2 * 65], sp[3 * 65]); o.z = cvt_pk_bf16(sp[4 * 65], sp[5 * 65]); o.w = cvt_pk_bf16(sp[6 * 65], sp[7 * 65]);
          *(u32x4*)(WT + (size_t)(n0 + n) * K + k0 + k8) = o; } }
    __builtin_amdgcn_fence(__ATOMIC_RELEASE, "wavefront"); __builtin_amdgcn_wave_barrier(); __builtin_amdgcn_fence(__ATOMIC_ACQUIRE, "wavefront");
}

__device__ __forceinline__ void s5prep_item(PRef p, int layer, int g, int part, unsigned char* shm) {
    const int tid = otid();
    c2* pw = (c2*)shm;
    c2* bbar = pw + 2 * 64 * 65;
    c2* cm = bbar + 2 * 64 * 16;
    c2* lamdt = cm + 2 * 16 * 64;
    if (tid < 128) { const int dir = tid >> 6, pp = tid & 63; const int o = ((layer * 2 + dir) * 32 + g) * 64 + pp;
        const float st = expf(p.in[20][(layer * 2 + dir) * 32 + g]);
        lamdt[tid] = mkc2(fminf(p.in[18][o], -1e-4f) * st, p.in[19][o] * st); }
    __syncthreads();
    for (int i = tid; i < 2 * 64 * 65; i += 512) { const int dp = i / 65, d = i % 65; const c2 z = lamdt[dp];
        float s, c; sincosf((float)d * z.y, &s, &c); const float m = expf((float)d * z.x); pw[i] = mkc2(m * c, m * s); }
    for (int i = tid; i < 2 * 64 * 16; i += 512) { const int dp = i >> 4, j = i & 15, dir = dp >> 6, pp = dp & 63;
        const int o = ((layer * 2 + dir) * 32 + g) * 64 + pp; const c2 z = lamdt[dp];
        const float st = expf(p.in[20][(layer * 2 + dir) * 32 + g]);
        const c2 lam = mkc2(fminf(p.in[18][o], -1e-4f), p.in[19][o]);
        float s, c; sincosf(z.y, &s, &c); const float sh = sinf(0.5f * z.y);
        const c2 em1 = mkc2(expm1f(z.x) * c - 2.f * sh * sh, expf(z.x) * s);
        const float den = 1.f / (lam.x * lam.x + lam.y * lam.y);
        const c2 coef = mkc2((em1.x * lam.x + em1.y * lam.y) * den, (em1.y * lam.x - em1.x * lam.y) * den);
        (void)st;
        const c2 bm = mkc2(p.in[21][(size_t)o * 16 + j], p.in[22][(size_t)o * 16 + j]);
        bbar[i] = cmul(coef, bm); }
    for (int i = tid; i < 2 * 16 * 64; i += 512) { const int dir = i >> 10, ii = (i >> 6) & 15, pp = i & 63;
        const size_t o = ((size_t)((layer * 2 + dir) * 32 + g) * 16 + ii) * 64 + pp; cm[i] = mkc2(p.in[23][o], p.in[24][o]); }
    __syncthreads();
    bf16_t* E = (bf16_t*)(p.ws + O_S5E); bf16_t* G = (bf16_t*)(p.ws + O_S5G); bf16_t* KT = (bf16_t*)(p.ws + O_S5K); c2* LT = (c2*)(p.ws + O_S5LT);
    if (part == 0 && tid < 128) { const int dir = tid >> 6, pp = tid & 63; LT[(dir * 32 + g) * 64 + pp] = pw[(dir * 64 + pp) * 65 + 64]; }
    for (int i = tid; i < 2 * 32 * 1024; i += 512) { const int dir = i >> 15, rr = (i >> 10) & 31, k = i & 1023; const int row = part * 32 + rr, pp = row >> 1, ri = row & 1, s = k >> 4, j = k & 15;
        const c2 w = cmul(pw[(dir * 64 + pp) * 65 + (dir == 0 ? 63 - s : s)], bbar[(dir * 64 + pp) * 16 + j]);
        E[((size_t)(dir * 32 + g) * 128 + row) * 1024 + k] = f2bf(ri ? w.y : w.x); }
    for (int i = tid; i < 2 * 256 * 128; i += 512) { const int dir = i >> 15, rr = (i >> 7) & 255, k = i & 127; const int t = part * 16 + (rr >> 4), ii = rr & 15, pp = k >> 1, ri = k & 1;
        const c2 w = cmul(cm[(dir * 16 + ii) * 64 + pp], pw[(dir * 64 + pp) * 65 + (dir == 0 ? t + 1 : 64 - t)]);
        G[((size_t)(dir * 32 + g) * 1024 + t * 16 + ii) * 128 + k] = f2bf(ri ? -w.y : w.x); }
    { const int pair = tid & 255, ii = pair >> 4, j = pair & 15, half = tid >> 8;
      const int dir = part < 2 ? 1 : 0;
      float* psum = (float*)(shm + 100352);
#pragma unroll 1
      for (int ph = 0; ph < 2; ++ph) {
          c2 cb[32];
#pragma unroll
          for (int q = 0; q < 32; ++q) { const int pp = ph * 32 + q; cb[q] = cmul(cm[(dir * 16 + ii) * 64 + pp], bbar[(dir * 64 + pp) * 16 + j]);
              if ((q & 7) == 7) asm volatile("" : "+v"(cb[q].x), "+v"(cb[q].y) :: "memory"); }
#pragma unroll 1
          for (int k = 0; k < 16; ++k) { const int dd = part * 32 + half * 16 + k;
              if (dd > 126) continue;
              const int d = dir ? 63 - dd : dd - 63;
              const c2* pwd = pw + (size_t)(dir * 64 + ph * 32) * 65 + d;
              float acc = ph ? psum[k * 512 + tid] : 0.f;
#pragma unroll
              for (int q = 0; q < 32; ++q) { const c2 w = pwd[q * 65]; acc += cb[q].x * w.x - cb[q].y * w.y;
                  if ((q & 7) == 7) asm volatile("" : "+v"(acc) :: "memory"); }
              if (ph == 0) { psum[k * 512 + tid] = acc; continue; }
              if (dd == 63) {
                  for (int pp = 0; pp < 64; ++pp) { const c2 w = cmul(cm[(0 * 16 + ii) * 64 + pp], bbar[(0 * 64 + pp) * 16 + j]); acc += w.x; } }
              KT[((size_t)g * 127 + dd) * 256 + ii * 16 + j] = f2bf(acc); } } }
    __syncthreads();
}

__device__ __forceinline__ void hyfilter_item(PRef p, int layer, bool isctx, int cg4, unsigned char* shm) {
    const int tid = otid(), hb = tid >> 8, ht = tid & 255, lane = tid & 63, wave = tid >> 6, c0 = cg4 * 4;
    const int L = isctx ? 256 : 4096, logN = isctx ? 9 : 13, N = 2 * L;
    const LAS c2* tw = (const LAS c2*)(shm + SCR_OFF + SCR_TW);
    const float* hid = (const float*)(p.ws + O_HID) + (size_t)(layer * 4352 + (isctx ? 4096 : 0)) * 64;
    c2* KF0b = isctx ? (c2*)(p.ws + O_KFC) + (size_t)c0 * 512 : (c2*)(p.ws + O_KF) + (size_t)c0 * 8192;
    c2* KF1b = isctx ? (c2*)(p.ws + O_KFC) + (size_t)(512 + c0) * 512 : (c2*)(p.ws + O_KF) + (size_t)(512 + c0) * 8192;
    float* red = (float*)shm;
    __syncthreads();
    const int fr = lane & 15, fq = lane >> 4;
    const int cdir = fr >> 3, co = (fr >> 2) & 1, ccc = fr & 3;
    bf16x8 bw[2];
    { const float* wp = p.in[14] + (size_t)layer * 64 * 2048 + cdir * 1024 + co * 512 + c0 + ccc;
#pragma unroll
      for (int kk = 0; kk < 2; ++kk) { float wv[8];
#pragma unroll
          for (int i = 0; i < 8; ++i) wv[i] = wp[(size_t)(kk * 32 + fq * 8 + i) * 2048];
          u32x4 w; w.x = cvt_pk_bf16(wv[0], wv[1]); w.y = cvt_pk_bf16(wv[2], wv[3]); w.z = cvt_pk_bf16(wv[4], wv[5]); w.w = cvt_pk_bf16(wv[6], wv[7]); bw[kk] = mk8(w); } }
    const float mind = -4.605170185988091f / 1.5f, maxd = -4.605170185988091f / 0.3f;
    const float adelta = fabsf(mind + (float)(c0 + ccc) * ((maxd - mind) / 511.f));
    float* ST = (float*)(KF0b + (size_t)ccc * N) + co;
    if (tid < 8) ((float*)(KF0b + (size_t)(tid & 3) * N))[2 * L + (tid >> 2)] = 0.f;
    float l1 = 0.f;
#pragma unroll 4
    for (int dt = wave; dt < L / 16; dt += 8) {
        const float* hr = hid + (size_t)(dt * 16 + fr) * 64 + fq * 8;
        f32x4 acc = (f32x4){0.f, 0.f, 0.f, 0.f};
#pragma unroll
        for (int kk = 0; kk < 2; ++kk) { const f32x4 x0 = *(const f32x4*)(hr + kk * 32), x1 = *(const f32x4*)(hr + kk * 32 + 4);
            u32x4 w; w.x = cvt_pk_bf16(x0[0], x0[1]); w.y = cvt_pk_bf16(x0[2], x0[3]); w.z = cvt_pk_bf16(x1[0], x1[1]); w.w = cvt_pk_bf16(x1[2], x1[3]);
            acc = __builtin_amdgcn_mfma_f32_16x16x32_bf16(mk8(w), bw[kk], acc, 0, 0, 0); }
#pragma unroll
        for (int r = 0; r < 4; ++r) { const int d = dt * 16 + fq * 4 + r; const float t = (float)d / (float)(L - 1);
            const float v = acc[r] * expf(-t * adelta);
            if (cdir == 0) { ST[2 * d] = v; l1 += fabsf(v); }
            else if (d >= 1) { ST[2 * (N - d)] = v; l1 += fabsf(v); } } }
    l1 += __shfl_xor(l1, 16); l1 += __shfl_xor(l1, 32);
    if (lane < 16) red[wave * 16 + lane] = l1;
    __threadfence();
    __syncthreads();
    __builtin_amdgcn_fence(__ATOMIC_ACQUIRE, "agent");
    LAS float* tot = (LAS float*)(shm + SCR_OFF);
    if (tid < 8) { float v = 0.f;
#pragma unroll
        for (int w = 0; w < 8; ++w) v += red[w * 16 + tid] + red[w * 16 + 8 + tid];
        tot[tid] = v; }
    __syncthreads();
    LAS c2* buf = (LAS c2*)shm + hb * FFT_PAD;
#pragma unroll 1
    for (int pr = 0; pr < 2; ++pr) { const int cc = 2 * pr + hb;
        const float inv0 = 0.5f / (tot[cc] * (float)N), inv1 = 0.5f / (tot[4 + cc] * (float)N);
        const c2* Z = KF0b + (size_t)cc * N;
#pragma unroll 8
        for (int i = ht; i < N; i += 256) buf[PHYS(i)] = Z[i];
        fft_fwd(buf, logN, tw, ht);
        c2* K0 = KF0b + (size_t)cc * N; c2* K1 = KF1b + (size_t)cc * N;
#pragma unroll 4
        for (int q = ht; q < N; q += 256) {
            const unsigned f = __brev((unsigned)q) >> (32 - logN);
            const unsigned q2 = __brev(((unsigned)N - f) & (unsigned)(N - 1)) >> (32 - logN);
            const c2 za = buf[PHYS(q)], zb = buf[PHYS((int)q2)];
            K0[q] = mkc2((za.x + zb.x) * inv0, (za.y - zb.y) * inv0);
            K1[q] = mkc2((za.y + zb.y) * inv1, (zb.x - za.x) * inv1); }
        __syncthreads(); }
}

__device__ __forceinline__ void xn_row(const float* hrow, const float* g, const float* shift, const float* scale, bf16_t* orow, int lane) {
    const float4* xr = (const float4*)hrow + lane;
    float4 v[8]; float s = 0.f;
#pragma unroll
    for (int j = 0; j < 8; ++j) { v[j] = xr[64 * j]; s += v[j].x * v[j].x + v[j].y * v[j].y + v[j].z * v[j].z + v[j].w * v[j].w; }
    const float r = rsqrtf(wave_sum(s) * (1.f / D) + 1e-6f);
    u32x2* o = (u32x2*)orow + lane;
#pragma unroll
    for (int j = 0; j < 8; ++j) { const float4 gg = ((const float4*)g)[lane + 64 * j], sh = ((const float4*)shift)[lane + 64 * j], sc = ((const float4*)scale)[lane + 64 * j];
        u32x2 w; w.x = cvt_pk_bf16(v[j].x * r * gg.x * (1.f + sc.x) + sh.x, v[j].y * r * gg.y * (1.f + sc.y) + sh.y);
        w.y = cvt_pk_bf16(v[j].z * r * gg.z * (1.f + sc.z) + sh.z, v[j].w * r * gg.w * (1.f + sc.w) + sh.w);
        o[64 * j] = w; }
}
__device__ __forceinline__ void xn_row1(PRef p, int layer, int which  , int row, int lane, const float* hL, const float* hC) {
    const float* mod = (const float*)(p.ws + O_MOD);
    const bool isc = row >= RL; const int mr = isc ? 4 : (row >> 12);
    const float* m = mod + (size_t)(layer * 5 + mr) * 12288 + (which ? 3 * 2048 : 0);
    const float* hrow = isc ? hC + (size_t)(row - RL) * 2048 : hL + (size_t)row * 2048;
    xn_row(hrow, p.in[which ? 29 : 6] + layer * 2048, m, m + 2048, (bf16_t*)(p.ws + O_XN) + (size_t)row * 2048, lane);
}

__device__ __forceinline__ void phase_lprep(PRef p, int layer, unsigned char* shm, const float* hL_, const float* hC_) {
    constexpr int N_S5 = 128, T_IN = 32 * 80, T_OUT = 32 * 32, T_UP = 32 * 176, T_DOWN = 88 * 32, T_GLU = 64;
    const int tid = otid(), wave = tid >> 6, lane = tid & 63, gw = blockIdx.x * 8 + wave, ngw = gridDim.x * 8;
    for (int rep = 0; rep < NREP(11); ++rep)
    for (int it = blockIdx.x; it < 384 + N_S5; it += gridDim.x) {
        int r = it;
        if (r >= 256 && r < 384) continue;
        if (r < 256) {
#if EN_HY
            const bool isctx = r >= 128; const int q = r & 127; if (!isctx || layer == 0) hyfilter_item(p, layer, isctx, q, shm);
#endif
            continue; }
        r -= 384;
#if EN_S5
        s5prep_item(p, layer, r >> 2, r & 3, shm);
#endif
    }
    __syncthreads();
    constexpr int NT = T_IN + T_OUT + T_UP + T_DOWN + T_GLU;
    for (int rep = 0; rep < NREP(12); ++rep)
    for (int it = gw; it < NT; it += ngw) {
        int r = it;
        if (r < T_IN) { convT_tile(p.in[7] + (size_t)layer * 2048 * 5120, 2048, 5120, (bf16_t*)(p.ws + O_WT_IN), r, shm, wave, lane); continue; } r -= T_IN;
        if (r < T_OUT) { convT_tile(p.in[28] + (size_t)layer * 2048 * 2048, 2048, 2048, (bf16_t*)(p.ws + O_WT_OUT), r, shm, wave, lane); continue; } r -= T_OUT;
        if (r < T_UP) { convT_tile(p.in[30] + (size_t)layer * 2048 * 11264, 2048, 11264, (bf16_t*)(p.ws + O_WT_UP), r, shm, wave, lane); continue; } r -= T_UP;
        if (r < T_DOWN) { convT_tile(p.in[33] + (size_t)layer * 5632 * 2048, 5632, 2048, (bf16_t*)(p.ws + O_WT_DOWN), r, shm, wave, lane); continue; } r -= T_DOWN;
        convT_tile(p.in[26] + (size_t)layer * 512 * 512, 512, 512, (bf16_t*)(p.ws + O_WT_GLU), r, shm, wave, lane);
    }
    for (int row = gw; row < RT; row += ngw) xn_row1(p, layer, 0, row, lane, hL_, hC_);
}

__device__ __forceinline__ void wave_sync_lds() { __builtin_amdgcn_fence(__ATOMIC_RELEASE, "wavefront"); __builtin_amdgcn_wave_barrier(); __builtin_amdgcn_fence(__ATOMIC_ACQUIRE, "wavefront"); }
__device__ __forceinline__ void hyT_witem(PRef p, int layer, bool isctx, int tile, unsigned char* shm, int wave, int lane) {
    const int L = isctx ? 256 : 4096, ntt = L / 32;
    const int b = tile / (ntt * 48), rem = tile % (ntt * 48), t0 = (rem / 48) * 32, c0 = (rem % 48) * 32;
    const bf16_t* A = (const bf16_t*)(p.ws + O_A) + (size_t)(isctx ? RL + b * 256 : b * 4096) * NIN;
    bf16_t* T = isctx ? (bf16_t*)(p.ws + O_HYTC) : (bf16_t*)(p.ws + O_HYT);
    float* X = (float*)shm + wave * (34 * 33);
#pragma unroll
    for (int i = 0; i < 3; ++i) { const int rr = 16 * i + (lane >> 2), c8 = (lane & 3) * 8, t = t0 - 1 + rr;
        if (rr < 34) { u32x4 v = (u32x4){0u, 0u, 0u, 0u};
            if (t >= 0 && t < L) v = *(const u32x4*)(A + (size_t)t * NIN + c0 + c8);
            float* d = X + rr * 33 + c8; d[0] = bflo(v.x); d[1] = bfhi(v.x); d[2] = bflo(v.y); d[3] = bfhi(v.y); d[4] = bflo(v.z); d[5] = bfhi(v.z); d[6] = bflo(v.w); d[7] = bfhi(v.w); } }
    wave_sync_lds();
    { const int cl = lane >> 1, t16 = (lane & 1) * 16, c = c0 + cl;
      const float w0 = p.in[8][(layer * 3 + 0) * 1536 + c], w1 = p.in[8][(layer * 3 + 1) * 1536 + c], w2 = p.in[8][(layer * 3 + 2) * 1536 + c], bb = p.in[9][layer * 1536 + c];
      float o[16];
#pragma unroll
      for (int j = 0; j < 16; ++j) { const int rr = t16 + j + 1; o[j] = w0 * X[(rr - 1) * 33 + cl] + w1 * X[rr * 33 + cl] + w2 * X[(rr + 1) * 33 + cl] + bb; }
      u32x4 wa, wb; wa.x = cvt_pk_bf16(o[0], o[1]); wa.y = cvt_pk_bf16(o[2], o[3]); wa.z = cvt_pk_bf16(o[4], o[5]); wa.w = cvt_pk_bf16(o[6], o[7]);
      wb.x = cvt_pk_bf16(o[8], o[9]); wb.y = cvt_pk_bf16(o[10], o[11]); wb.z = cvt_pk_bf16(o[12], o[13]); wb.w = cvt_pk_bf16(o[14], o[15]);
      bf16_t* dst = T + ((size_t)(b * 1536 + c)) * L + t0 + t16;
      *(u32x4*)dst = wa; *(u32x4*)(dst + 8) = wb; }
    wave_sync_lds();
}

constexpr int LDK = 136;
__device__ __forceinline__ int tsw(int row, int col) { return row * LDK + ((col + 8 * (row >> 3)) & 127); }
__device__ __forceinline__ void retkv_item(PRef p, int layer, int item, unsigned char* shm) {
    const int tid = otid(), lane = tid & 63, wave = tid >> 6, fr = lane & 15, fq = lane >> 4;
    int b, h, n, row0, cidx;
    if (item < 1024) { b = item >> 8; h = (item >> 5) & 7; n = item & 31; row0 = b * 4096 + n * 128; cidx = 2 + n; }
    else { const int q = item - 1024; b = q >> 4; h = (q >> 1) & 7; n = q & 1; row0 = RL + b * 256 + n * 128; cidx = n; }
    const float lgf = -expf(p.in[17][(layer * 2 + 0) * 8 + h]), lgb = -expf(p.in[17][(layer * 2 + 1) * 8 + h]);
    const bf16_t* A = (const bf16_t*)(p.ws + O_A);
    bf16_t* kTf = (bf16_t*)shm; bf16_t* kTb = kTf + 64 * LDK; bf16_t* vT = kTb + 64 * LDK;
#pragma unroll
    for (int i = 0; i < 2; ++i) { const int idx = tid + 512 * i, m = idx >> 3, d8 = (idx & 7) * 8;
        const u32x4 v = *(const u32x4*)(A + (size_t)(row0 + m) * NIN + C_K + h * 64 + d8);
        const float pf = 0.125f * expf((float)(127 - m) * lgf), pb = 0.125f * expf((float)m * lgb);
        const unsigned ww[4] = {v.x, v.y, v.z, v.w};
#pragma unroll
        for (int j = 0; j < 4; ++j) { const float lo = bflo(ww[j]), hi = bfhi(ww[j]);
            kTf[tsw(d8 + 2 * j, m)] = f2bf(lo * pf); kTf[tsw(d8 + 2 * j + 1, m)] = f2bf(hi * pf);
            kTb[tsw(d8 + 2 * j, m)] = f2bf(lo * pb); kTb[tsw(d8 + 2 * j + 1, m)] = f2bf(hi * pb); } }
#pragma unroll
    for (int i = 0; i < 4; ++i) { const int idx = tid + 512 * i, m = idx >> 4, e8 = (idx & 15) * 8;
        const u32x4 v = *(const u32x4*)(A + (size_t)(row0 + m) * NIN + C_V + h * 128 + e8);
        const unsigned ww[4] = {v.x, v.y, v.z, v.w};
#pragma unroll
        for (int j = 0; j < 4; ++j) { vT[tsw(e8 + 2 * j, m)] = (bf16_t)(ww[j] & 0xffffu); vT[tsw(e8 + 2 * j + 1, m)] = (bf16_t)(ww[j] >> 16); } }
    __syncthreads();
    const int dir = wave >> 2, mt = wave & 3;
    const bf16_t* kT = dir ? kTb : kTf;
    f32x4 acc[8];
#pragma unroll
    for (int nt = 0; nt < 8; ++nt) acc[nt] = (f32x4){0.f, 0.f, 0.f, 0.f};
#pragma unroll
    for (int kk = 0; kk < 4; ++kk) { const bf16x8 af = *(const bf16x8*)(kT + tsw(16 * mt + fr, kk * 32 + fq * 8));
#pragma unroll
        for (int nt = 0; nt < 8; ++nt) { const bf16x8 bf = *(const bf16x8*)(vT + tsw(16 * nt + fr, kk * 32 + fq * 8));
            acc[nt] = __builtin_amdgcn_mfma_f32_16x16x32_bf16(af, bf, acc[nt], 0, 0, 0); } }
    float* ST = (float*)(p.ws + O_RETST) + ((size_t)((b * 8 + h) * 2 + dir) * 34 + cidx) * 8192;
#pragma unroll
    for (int nt = 0; nt < 8; ++nt)
#pragma unroll
        for (int r = 0; r < 4; ++r) ST[(16 * mt + fq * 4 + r) * 128 + 16 * nt + fr] = acc[nt][r];
    __syncthreads();
}

__device__ __forceinline__ bf16x8 s5_ufrag(const bf16_t* A, int b, int g, int nt, int kk, int fr, int fq) {
    const int s = 2 * kk + (fq >> 1);
    const int row = (nt < 4) ? (b * 4096 + (16 * nt + fr) * 64 + s) : (RL + b * 256 + (fr & 3) * 64 + s);
    return *(const bf16x8*)(A + (size_t)row * NIN + C_U + g * 16 + (fq & 1) * 8);
}
constexpr int S5_UP = 2064;
__device__ __forceinline__ void s5_stage_u(const bf16_t* A, unsigned char* ul, int b, int g, int nt, int tid) {
#pragma unroll
    for (int i = 0; i < 4; ++i) { const int idx = tid + 512 * i, half = idx & 1, tok = (idx >> 1) & 63, ch = idx >> 7;
        const int row = (nt < 4) ? (b * 4096 + (16 * nt + ch) * 64 + tok) : (RL + b * 256 + (ch & 3) * 64 + tok);
        *(u32x4*)(ul + ch * S5_UP + tok * 32 + half * 16) = *(const u32x4*)(A + (size_t)row * NIN + C_U + g * 16 + half * 8); }
}
__device__ __forceinline__ void s5inc_item(PRef p, int item, unsigned char* shm) {
    const int tid = otid(), lane = tid & 63, wave = tid >> 6, fr = lane & 15, fq = lane >> 4;
    const int g = item >> 3, dir = (item >> 2) & 1, b = item & 3;
    const bf16_t* A = (const bf16_t*)(p.ws + O_A);
    const bf16_t* E = (const bf16_t*)(p.ws + O_S5E) + ((size_t)(dir * 32 + g) * 128 + 16 * wave + fr) * 1024 + fq * 8;
    bf16x8 af[32];
#pragma unroll
    for (int kk = 0; kk < 32; ++kk) af[kk] = *(const bf16x8*)(E + kk * 32);
    float* ST = (float*)(p.ws + O_S5ST) + (size_t)((g * 2 + dir) * 4 + b) * 68 * 128;
#pragma unroll 1
    for (int nt = 0; nt < 5; ++nt) {
        __syncthreads();
        s5_stage_u(A, shm, b, g, nt, tid);
        __syncthreads();
        f32x4 acc = (f32x4){0.f, 0.f, 0.f, 0.f};
#pragma unroll
        for (int kk = 0; kk < 32; ++kk) acc = __builtin_amdgcn_mfma_f32_16x16x32_bf16(af[kk], *(const bf16x8*)(shm + fr * S5_UP + kk * 64 + fq * 16), acc, 0, 0, 0);
        if (nt < 4 || fr < 4) { const int cidx = nt < 4 ? 4 + 16 * nt + fr : fr; *(f32x4*)(ST + (size_t)cidx * 128 + 16 * wave + fq * 4) = acc; }
    }
    __syncthreads();
}

__device__ __forceinline__ void phase_m1(PRef p, int layer, unsigned char* shm) {
    constexpr int N_RKV = 1088, N_S5I = 256;
    for (int it = blockIdx.x; it < N_S5I + N_RKV; it += gridDim.x) {
        int r = it;
        if (r < N_S5I) {
#if EN_S5
            for (int rep = 0; rep < NREP(8); ++rep) s5inc_item(p, r, shm);
#endif
            continue; }
        r -= N_S5I;
#if EN_RET
        for (int rep = 0; rep < NREP(9); ++rep) retkv_item(p, layer, r, shm);
#endif
    }
    __syncthreads();
#if EN_HY
    const int n_hyt = (layer == 0) ? 24576 + 1536 : 24576;
    const int tid = otid(), wave = tid >> 6, lane = tid & 63;
    for (int it = blockIdx.x * 8 + wave; it < n_hyt; it += gridDim.x * 8)
        for (int rep = 0; rep < NREP(10); ++rep) { if (it < 24576) hyT_witem(p, layer, false, it, shm, wave, lane); else hyT_witem(p, layer, true, it - 24576, shm, wave, lane); }
#endif
}

__device__ __forceinline__ void unpack8(u32x4 v, float (&o)[8]) { o[0] = bflo(v.x); o[1] = bfhi(v.x); o[2] = bflo(v.y); o[3] = bfhi(v.y); o[4] = bflo(v.z); o[5] = bfhi(v.z); o[6] = bflo(v.w); o[7] = bfhi(v.w); }
template <bool isctx>
__device__ __forceinline__ void hyconv_item(PRef p, int layer, int item, unsigned char* shm) {
    const int tid = otid(), hb = tid >> 8, ht = tid & 255;
    const int bp = item >> 8, c = 2 * (item & 255) + hb, b0 = 2 * bp, b1 = b0 + 1;
    const int L = isctx ? 256 : 4096, logN = isctx ? 9 : 13, N = 2 * L;
    LAS c2* buf = (LAS c2*)shm + hb * FFT_PAD;
    const LAS c2* tw = (const LAS c2*)(shm + SCR_OFF + SCR_TW);
    const bf16_t* T = isctx ? (const bf16_t*)(p.ws + O_HYTC) : (const bf16_t*)(p.ws + O_HYT);
    float* Y = isctx ? (float*)(p.ws + O_HYYC) : (float*)(p.ws + O_HYY);
    const c2* KF0 = isctx ? (const c2*)(p.ws + O_KFC) + (size_t)c * 512 : (const c2*)(p.ws + O_KF) + (size_t)c * 8192;
    const c2* KF1 = isctx ? (const c2*)(p.ws + O_KFC) + (size_t)(512 + c) * 512 : (const c2*)(p.ws + O_KF) + (size_t)(512 + c) * 8192;
    const bf16_t* v0 = T + (size_t)(b0 * 1536 + c) * L; const bf16_t* v1 = T + (size_t)(b1 * 1536 + c) * L;
    float* y0 = Y + (size_t)(b0 * 512 + c) * L; float* y1 = Y + (size_t)(b1 * 512 + c) * L;
    const float bias0 = p.in[16][(layer * 2 + 0) * 512 + c], bias1 = p.in[16][(layer * 2 + 1) * 512 + c];
    __syncthreads();
#pragma unroll 1
    for (int t8 = ht * 8; t8 < L; t8 += 2048) { float a[8], b[8]; unpack8(*(const u32x4*)(v0 + t8), a); unpack8(*(const u32x4*)(v1 + t8), b);
#pragma unroll
        for (int j = 0; j < 8; ++j) { buf[PHYS(t8 + j)] = mkc2(a[j], b[j]); buf[PHYS(t8 + j + L)] = mkc2(0.f, 0.f); } }
    if (!isctx) fft_conv13(buf, KF0, tw, ht);
    else { fft_fwd(buf, logN, tw, ht);
#pragma unroll 2
        for (int i = ht; i < N; i += 256) buf[PHYS(i)] = cmul(buf[PHYS(i)], KF0[i]);
        fft_inv(buf, logN, tw, ht); }
#pragma unroll 1
    for (int t8 = ht * 8; t8 < L; t8 += 2048) { float a[8], b[8], xa[8], xb[8];
        unpack8(*(const u32x4*)(v0 + t8), a); unpack8(*(const u32x4*)(v1 + t8), b);
        unpack8(*(const u32x4*)(v0 + (size_t)512 * L + t8), xa); unpack8(*(const u32x4*)(v1 + (size_t)512 * L + t8), xb);
        float za[8], zb[8];
#pragma unroll
        for (int j = 0; j < 8; ++j) { const c2 cv = buf[PHYS(t8 + j)]; za[j] = xa[j] * (cv.x + bias0 * a[j]); zb[j] = xb[j] * (cv.y + bias0 * b[j]);
            buf[PHYS(t8 + j)] = mkc2(za[j], zb[j]); buf[PHYS(t8 + j + L)] = mkc2(0.f, 0.f); }
        *(float4*)(y0 + t8) = make_float4(za[0], za[1], za[2], za[3]); *(float4*)(y0 + t8 + 4) = make_float4(za[4], za[5], za[6], za[7]);
        *(float4*)(y1 + t8) = make_float4(zb[0], zb[1], zb[2], zb[3]); *(float4*)(y1 + t8 + 4) = make_float4(zb[4], zb[5], zb[6], zb[7]); }
    if (!isctx) fft_conv13(buf, KF1, tw, ht);
    else { fft_fwd(buf, logN, tw, ht);
#pragma unroll 2
        for (int i = ht; i < N; i += 256) buf[PHYS(i)] = cmul(buf[PHYS(i)], KF1[i]);
        fft_inv(buf, logN, tw, ht); }
#pragma unroll 1
    for (int t8 = ht * 8; t8 < L; t8 += 2048) { float xa[8], xb[8];
        unpack8(*(const u32x4*)(v0 + (size_t)1024 * L + t8), xa); unpack8(*(const u32x4*)(v1 + (size_t)1024 * L + t8), xb);
        const float4 p0 = *(const float4*)(y0 + t8), p1 = *(const float4*)(y0 + t8 + 4), q0 = *(const float4*)(y1 + t8), q1 = *(const float4*)(y1 + t8 + 4);
        const float za[8] = {p0.x, p0.y, p0.z, p0.w, p1.x, p1.y, p1.z, p1.w}, zb[8] = {q0.x, q0.y, q0.z, q0.w, q1.x, q1.y, q1.z, q1.w};
        float oa[8], ob[8];
#pragma unroll
        for (int j = 0; j < 8; ++j) { const c2 cv = buf[PHYS(t8 + j)]; oa[j] = xa[j] * (cv.x + bias1 * za[j]); ob[j] = xb[j] * (cv.y + bias1 * zb[j]); }
        *(float4*)(y0 + t8) = make_float4(oa[0], oa[1], oa[2], oa[3]); *(float4*)(y0 + t8 + 4) = make_float4(oa[4], oa[5], oa[6], oa[7]);
        *(float4*)(y1 + t8) = make_float4(ob[0], ob[1], ob[2], ob[3]); *(float4*)(y1 + t8 + 4) = make_float4(ob[4], ob[5], ob[6], ob[7]); }
    __syncthreads();
}

__device__ __forceinline__ void phase_m2(PRef p, int layer, unsigned char* shm, bool scans) {
    const int gid = blockIdx.x * 512 + otid(), gsz = scans ? gridDim.x * 512 : 0x40000000;
#if EN_RET
    for (int ch = scans ? gid : 0x7fffffff - gsz; ch < 64 * 8192; ch += gsz) { const int bhd = ch >> 13, el = ch & 8191, dir = bhd & 1, h = (bhd >> 1) & 7;
        const float dec = expf(-128.f * expf(p.in[17][(layer * 2 + dir) * 8 + h]));
        float* base = (float*)(p.ws + O_RETST) + (size_t)bhd * 34 * 8192 + el;
        float inc[34];
#pragma unroll
        for (int sidx = 0; sidx < 34; ++sidx) { const int cidx = dir == 0 ? sidx : (sidx < 2 ? 1 - sidx : 35 - sidx); inc[sidx] = base[(size_t)cidx * 8192]; }
        float st = 0.f;
#pragma unroll
        for (int sidx = 0; sidx < 34; ++sidx) { const int cidx = dir == 0 ? sidx : (sidx < 2 ? 1 - sidx : 35 - sidx);
            base[(size_t)cidx * 8192] = st; st = dec * st + inc[sidx]; } }
#endif
#if EN_S5
    for (int ch = scans ? gid : 0x7fffffff - gsz; ch < 256 * 64; ch += gsz) { const int gdb = ch >> 6, pp = ch & 63, g = gdb >> 3, dir = (gdb >> 2) & 1;
        const c2 lt = ((const c2*)(p.ws + O_S5LT))[(dir * 32 + g) * 64 + pp];
        c2* base = (c2*)((float*)(p.ws + O_S5ST) + (size_t)gdb * 68 * 128) + pp;
        c2 st = mkc2(0.f, 0.f);
#pragma unroll 1
        for (int half = 0; half < 2; ++half) {
            c2 inc[34];
#pragma unroll
            for (int j = 0; j < 34; ++j) { const int sidx = half * 34 + j; const int cidx = dir == 0 ? sidx : (sidx < 4 ? 3 - sidx : 71 - sidx); inc[j] = base[(size_t)cidx * 64]; }
#pragma unroll
            for (int j = 0; j < 34; ++j) { const int sidx = half * 34 + j; const int cidx = dir == 0 ? sidx : (sidx < 4 ? 3 - sidx : 71 - sidx);
                base[(size_t)cidx * 64] = st; const c2 ns = cmul(lt, st); st = mkc2(ns.x + inc[j].x, ns.y + inc[j].y); } } }
#endif
#if EN_HY
    const int total = (layer == 0) ? 1024 : 512;
    for (int it = blockIdx.x; it < total; it += gridDim.x) { if (it < 512) hyconv_item<false>(p, layer, it, shm); else hyconv_item<true>(p, layer, it - 512, shm); }
#endif
}

__device__ __forceinline__ bf16x8 scale8(bf16x8 q, float s) {
    const u32x4 w = un8(q); u32x4 o;
    o.x = cvt_pk_bf16(bflo(w.x) * s, bfhi(w.x) * s); o.y = cvt_pk_bf16(bflo(w.y) * s, bfhi(w.y) * s);
    o.z = cvt_pk_bf16(bflo(w.z) * s, bfhi(w.z) * s); o.w = cvt_pk_bf16(bflo(w.w) * s, bfhi(w.w) * s);
    return mk8(o);
}
__device__ __forceinline__ void retout_item(PRef p, int layer, int item, unsigned char* shm) {
    const int tid = otid(), lane = tid & 63, wave = tid >> 6, fr = lane & 15, fq = lane >> 4;
    int b, h, n, row0, cidx;
    if (item < 1024) { b = item >> 8; h = (item >> 5) & 7; n = item & 31; row0 = b * 4096 + n * 128; cidx = 2 + n; }
    else { const int q = item - 1024; b = q >> 4; h = (q >> 1) & 7; n = q & 1; row0 = RL + b * 256 + n * 128; cidx = n; }
    const float lgf = -expf(p.in[17][(layer * 2 + 0) * 8 + h]), lgb = -expf(p.in[17][(layer * 2 + 1) * 8 + h]);
    const bf16_t* A = (const bf16_t*)(p.ws + O_A);
    bf16_t* MIX = (bf16_t*)(p.ws + O_XN);
    bf16_t* vT = (bf16_t*)shm;
    bf16_t* sTf = vT + 128 * LDK;
    bf16_t* sTb = sTf + 128 * 72;
    bf16_t* Pw = sTb + 128 * 72 + wave * 16 * LDK;
#pragma unroll
    for (int i = 0; i < 4; ++i) { const int idx = tid + 512 * i, m = idx >> 4, e8 = (idx & 15) * 8;
        const u32x4 v = *(const u32x4*)(A + (size_t)(row0 + m) * NIN + C_V + h * 128 + e8);
        const unsigned ww[4] = {v.x, v.y, v.z, v.w};
#pragma unroll
        for (int j = 0; j < 4; ++j) { vT[tsw(e8 + 2 * j, m)] = (bf16_t)(ww[j] & 0xffffu); vT[tsw(e8 + 2 * j + 1, m)] = (bf16_t)(ww[j] >> 16); } }
    { const float* SF = (const float*)(p.ws + O_RETST) + ((size_t)((b * 8 + h) * 2 + 0) * 34 + cidx) * 8192;
      const float* SB = (const float*)(p.ws + O_RETST) + ((size_t)((b * 8 + h) * 2 + 1) * 34 + cidx) * 8192;
#pragma unroll 4
      for (int i = 0; i < 16; ++i) { const int idx = tid + 512 * i, d = idx >> 7, e = idx & 127;
          sTf[e * 72 + d] = f2bf(SF[idx]); sTb[e * 72 + d] = f2bf(SB[idx]); } }
    __syncthreads();
    bf16x8 qa[2];
#pragma unroll
    for (int kk = 0; kk < 2; ++kk) qa[kk] = *(const bf16x8*)(A + (size_t)(row0 + 16 * wave + fr) * NIN + C_Q + h * 64 + kk * 32 + fq * 8);
#pragma unroll
    for (int nt = 0; nt < 8; ++nt) { f32x4 s = (f32x4){0.f, 0.f, 0.f, 0.f};
#pragma unroll
        for (int kk = 0; kk < 2; ++kk) { const bf16x8 kb = *(const bf16x8*)(A + (size_t)(row0 + 16 * nt + fr) * NIN + C_K + h * 64 + kk * 32 + fq * 8);
            s = __builtin_amdgcn_mfma_f32_16x16x32_bf16(qa[kk], kb, s, 0, 0, 0); }
        const int m = 16 * nt + fr;
#pragma unroll
        for (int r = 0; r < 4; ++r) { const int c = 16 * wave + fq * 4 + r; const float dd = (float)(c - m);
            const float dec = (m <= c) ? expf(dd * lgf) : expf(-dd * lgb);
            Pw[(fq * 4 + r) * LDK + m] = f2bf(s[r] * 0.125f * dec); } }
    __syncthreads();
    f32x4 acc[8];
#pragma unroll
    for (int et = 0; et < 8; ++et) acc[et] = (f32x4){0.f, 0.f, 0.f, 0.f};
#pragma unroll
    for (int kk = 0; kk < 4; ++kk) { const bf16x8 af = *(const bf16x8*)(Pw + fr * LDK + kk * 32 + fq * 8);
#pragma unroll
        for (int et = 0; et < 8; ++et) { const bf16x8 bf = *(const bf16x8*)(vT + tsw(16 * et + fr, kk * 32 + fq * 8));
            acc[et] = __builtin_amdgcn_mfma_f32_16x16x32_bf16(af, bf, acc[et], 0, 0, 0); } }
    { const int ca = 16 * wave + fr;
      const float sf = expf((float)(ca + 1) * lgf), sb = expf((float)(128 - ca) * lgb);
#pragma unroll
      for (int kk = 0; kk < 2; ++kk) { const bf16x8 af = scale8(qa[kk], sf), ab = scale8(qa[kk], sb);
#pragma unroll
          for (int et = 0; et < 8; ++et) { const bf16x8 b1 = *(const bf16x8*)(sTf + (16 * et + fr) * 72 + kk * 32 + fq * 8);
              acc[et] = __builtin_amdgcn_mfma_f32_16x16x32_bf16(af, b1, acc[et], 0, 0, 0);
              const bf16x8 b2 = *(const bf16x8*)(sTb + (16 * et + fr) * 72 + kk * 32 + fq * 8);
              acc[et] = __builtin_amdgcn_mfma_f32_16x16x32_bf16(ab, b2, acc[et], 0, 0, 0); } } }
#pragma unroll
    for (int r = 0; r < 4; ++r) { float ss = 0.f;
#pragma unroll
        for (int et = 0; et < 8; ++et) ss += acc[et][r] * acc[et][r];
        ss += __shfl_xor(ss, 1); ss += __shfl_xor(ss, 2); ss += __shfl_xor(ss, 4); ss += __shfl_xor(ss, 8);
        const float rinv = rsqrtf(ss * (1.f / 128.f) + 1e-6f);
        const size_t row = (size_t)(row0 + 16 * wave + fq * 4 + r);
#pragma unroll
        for (int et = 0; et < 8; ++et) { const int e = 16 * et + fr; const float gg = bf2f(A[row * NIN + C_G + h * 128 + e]);
            MIX[row * 2048 + 512 + h * 128 + e] = f2bf(acc[et][r] * rinv * gg * sigmoidf_(gg)); } }
    __syncthreads();
}

__device__ __forceinline__ void s5out_item(PRef p, int layer, int item, unsigned char* shm) {
    const int tid = otid(), lane = tid & 63, wave = tid >> 6, fr = lane & 15, fq = lane >> 4;
    const int g = item >> 3, b = (item >> 1) & 3, mh = item & 1;
    const bf16_t* A = (const bf16_t*)(p.ws + O_A);
    bf16_t* KT = (bf16_t*)shm;
    unsigned char* ul = shm + 65024;
    __syncthreads();
    { const u32x4* src = (const u32x4*)((const bf16_t*)(p.ws + O_S5K) + (size_t)g * 127 * 256); u32x4* dst = (u32x4*)shm;
      for (int i = tid; i < 127 * 256 / 8; i += 512) dst[i] = src[i]; }
    const int tb = 32 * mh + 4 * wave;
    bf16_t* Z = (bf16_t*)(p.ws + O_Z5);
    const f32x4 dv = *(const f32x4*)(p.in[25] + layer * 512 + g * 16 + fq * 4);
#pragma unroll 1
    for (int nt = 0; nt < (layer == 1 ? 4 : 5); ++nt) {
        __syncthreads();
        s5_stage_u(A, ul, b, g, nt, tid);
        __syncthreads();
        f32x4 acc[4];
#pragma unroll
        for (int mi = 0; mi < 4; ++mi) acc[mi] = (f32x4){0.f, 0.f, 0.f, 0.f};
#pragma unroll 4
        for (int kk = 0; kk < 32; ++kk) {
            const bf16x8 bfr = *(const bf16x8*)(ul + fr * S5_UP + kk * 64 + fq * 16);
            const int sq = 2 * kk + (fq >> 1);
#pragma unroll
            for (int mi = 0; mi < 4; ++mi) { const bf16x8 af = *(const bf16x8*)(KT + (tb + mi - sq + 63) * 256 + fr * 16 + (fq & 1) * 8);
                acc[mi] = __builtin_amdgcn_mfma_f32_16x16x32_bf16(af, bfr, acc[mi], 0, 0, 0); } }
        const int cidx = nt < 4 ? 4 + 16 * nt + fr : (fr & 3);
#pragma unroll
        for (int dir = 0; dir < 2; ++dir) {
            const bf16_t* G = (const bf16_t*)(p.ws + O_S5G) + (size_t)(dir * 32 + g) * 1024 * 128;
            const float* ST = (const float*)(p.ws + O_S5ST) + (size_t)((g * 2 + dir) * 4 + b) * 68 * 128 + (size_t)cidx * 128;
#pragma unroll
            for (int kk = 0; kk < 4; ++kk) {
                const f32x4 x0 = *(const f32x4*)(ST + kk * 32 + fq * 8), x1 = *(const f32x4*)(ST + kk * 32 + fq * 8 + 4);
                u32x4 w; w.x = cvt_pk_bf16(x0[0], x0[1]); w.y = cvt_pk_bf16(x0[2], x0[3]); w.z = cvt_pk_bf16(x1[0], x1[1]); w.w = cvt_pk_bf16(x1[2], x1[3]);
                const bf16x8 bfr = mk8(w);
#pragma unroll
                for (int mi = 0; mi < 4; ++mi) { const bf16x8 af = *(const bf16x8*)(G + (size_t)((tb + mi) * 16 + fr) * 128 + kk * 32 + fq * 8);
                    acc[mi] = __builtin_amdgcn_mfma_f32_16x16x32_bf16(af, bfr, acc[mi], 0, 0, 0); } } }
        if (nt < 4 || fr < 4) {
#pragma unroll
            for (int mi = 0; mi < 4; ++mi) { const int t = tb + mi; const size_t row = nt < 4 ? (size_t)(b * 4096 + (16 * nt + fr) * 64 + t) : (size_t)(RL + b * 256 + fr * 64 + t);
                const u32x2 uu = *(const u32x2*)(ul + fr * S5_UP + t * 32 + fq * 8);
                const f32x4 y = acc[mi];
                u32x2 w; w.x = cvt_pk_bf16(gelu_tanh(y[0] + dv[0] * bflo(uu.x)), gelu_tanh(y[1] + dv[1] * bfhi(uu.x)));
                w.y = cvt_pk_bf16(gelu_tanh(y[2] + dv[2] * bflo(uu.y)), gelu_tanh(y[3] + dv[3] * bfhi(uu.y)));
                *(u32x2*)(Z + row * 512 + g * 16 + fq * 4) = w; } }
    }
    __syncthreads();
}

__device__ __forceinline__ void hyback_witem(PRef p, bool isctx, int tile, unsigned char* shm, int wave, int lane) {
    const int L = isctx ? 256 : 4096, ntt = L / 32;
    const int b = tile / (ntt * 16), rem = tile % (ntt * 16), t0 = (rem / 16) * 32, c0 = (rem % 16) * 32;
    const float* Y = isctx ? (const float*)(p.ws + O_HYYC) : (const float*)(p.ws + O_HYY);
    bf16_t* MIX = (bf16_t*)(p.ws + O_XN) + (size_t)(isctx ? RL + b * 256 : b * 4096) * 2048;
    float* T = (float*)shm + wave * (32 * 33);
    { const int cl = lane >> 1, t16 = (lane & 1) * 16; const float4* sp = (const float4*)(Y + (size_t)(b * 512 + c0 + cl) * L + t0 + t16);
      float* d = T + cl * 33 + t16;
#pragma unroll
      for (int q = 0; q < 4; ++q) { const float4 a = sp[q]; d[4 * q] = a.x; d[4 * q + 1] = a.y; d[4 * q + 2] = a.z; d[4 * q + 3] = a.w; } }
    wave_sync_lds();
    { const int tl = lane >> 1, c16 = (lane & 1) * 16; const float* sp = T + c16 * 33 + tl;
      u32x4 wa, wb;
      wa.x = cvt_pk_bf16(sp[0], sp[33]); wa.y = cvt_pk_bf16(sp[2 * 33], sp[3 * 33]); wa.z = cvt_pk_bf16(sp[4 * 33], sp[5 * 33]); wa.w = cvt_pk_bf16(sp[6 * 33], sp[7 * 33]);
      wb.x = cvt_pk_bf16(sp[8 * 33], sp[9 * 33]); wb.y = cvt_pk_bf16(sp[10 * 33], sp[11 * 33]); wb.z = cvt_pk_bf16(sp[12 * 33], sp[13 * 33]); wb.w = cvt_pk_bf16(sp[14 * 33], sp[15 * 33]);
      bf16_t* dst = MIX + (size_t)(t0 + tl) * 2048 + c0 + c16;
      *(u32x4*)dst = wa; *(u32x4*)(dst + 8) = wb; }
    wave_sync_lds();
}

__device__ __forceinline__ void zero_mix_cols(PRef p, int col0, int ncols) {
    bf16_t* MIX = (bf16_t*)(p.ws + O_XN);
    for (size_t i = (size_t)blockIdx.x * 512 + otid(); i < (size_t)RT * ncols; i += (size_t)gridDim.x * 512) MIX[(i / ncols) * 2048 + col0 + (i % ncols)] = 0;
}

__device__ __forceinline__ void phase_m3(PRef p, int layer, unsigned char* shm) {
    constexpr int N_S5O = 256;
    const int N_RO = layer == 1 ? 1024 : 1088;
    for (int it = blockIdx.x; it < N_S5O + N_RO; it += gridDim.x) {
        int r = it;
        if (r < N_S5O) {
#if EN_S5
            for (int rep = 0; rep < NREP(8); ++rep) s5out_item(p, layer, r, shm);
#endif
            continue; }
        r -= N_S5O;
#if EN_RET
        for (int rep = 0; rep < NREP(9); ++rep) retout_item(p, layer, r, shm);
#endif
    }
    __syncthreads();
#if EN_HY
    const int n_hyb = (layer == 0) ? 8192 + 512 : 8192;
    const int tid = otid(), wave = tid >> 6, lane = tid & 63;
    for (int it = blockIdx.x * 8 + wave; it < n_hyb; it += gridDim.x * 8)
        for (int rep = 0; rep < NREP(10); ++rep) { if (it < 8192) hyback_witem(p, false, it, shm, wave, lane); else hyback_witem(p, true, it - 8192, shm, wave, lane); }
#else
    zero_mix_cols(p, 0, 512);
#endif
#if !EN_RET
    zero_mix_cols(p, 512, 1024);
#endif
#if !EN_S5
    zero_mix_cols(p, 1536, 512);
#endif
}

__device__ __forceinline__ void phase_conv(PRef p, int layer, int nseg) {
    const int tid = otid(), fg = tid & 63, xs = tid >> 6;
    bf16_t* GV = (bf16_t*)(p.ws + O_GV);
    const float* CW = p.in[31] + (size_t)layer * 9 * NFF; const float* CB = p.in[32] + (size_t)layer * NFF;
    for (int it = blockIdx.x; it < nseg * 11; it += gridDim.x) {
        const int seg = it / 11, f = (it % 11) * 512 + fg * 8;
        const bool isc = seg >= 256;
        float w[9][8], bias[8];
#pragma unroll
        for (int k = 0; k < 9; ++k) { const float4 a = *(const float4*)(CW + (size_t)k * NFF + f), bq = *(const float4*)(CW + (size_t)k * NFF + f + 4);
            w[k][0] = a.x; w[k][1] = a.y; w[k][2] = a.z; w[k][3] = a.w; w[k][4] = bq.x; w[k][5] = bq.y; w[k][6] = bq.z; w[k][7] = bq.w; }
        { const float4 a = *(const float4*)(CB + f), bq = *(const float4*)(CB + f + 4); bias[0] = a.x; bias[1] = a.y; bias[2] = a.z; bias[3] = a.w; bias[4] = bq.x; bias[5] = bq.y; bias[6] = bq.z; bias[7] = bq.w; }
        int W, x0; const bf16_t* lp[3]; bool lv[3];
        if (!isc) { const int b = seg >> 6, r = seg & 63; W = 64; x0 = 8 * xs;
#pragma unroll
            for (int ky = 0; ky < 3; ++ky) { const int yy = r + ky - 1; lv[ky] = (yy >= 0) && (yy < 64); lp[ky] = GV + ((size_t)b * 4096 + (size_t)(lv[ky] ? yy : r) * 64) * NUP + f; } }
        else { const int s2 = seg - 256, b = s2 >> 2, q = s2 & 3; W = 256; x0 = q * 64 + 8 * xs;
#pragma unroll
            for (int ky = 0; ky < 3; ++ky) { lv[ky] = (ky == 1); lp[ky] = GV + ((size_t)RL + b * 256) * NUP + f; } }
#pragma unroll 1
        for (int hx = 0; hx < 2; ++hx) { const int xb = x0 + 4 * hx;
            u32x4 gc[3][6], vv[4];
#pragma unroll
            for (int ky = 0; ky < 3; ++ky)
#pragma unroll
                for (int cx = 0; cx < 6; ++cx) { const int xx = xb - 1 + cx;
                    gc[ky][cx] = (lv[ky] && xx >= 0 && xx < W) ? *(const u32x4*)(lp[ky] + (size_t)xx * NUP) : (u32x4){0u, 0u, 0u, 0u}; }
#pragma unroll
            for (int xi = 0; xi < 4; ++xi) vv[xi] = *(const u32x4*)(lp[1] + (size_t)(xb + xi) * NUP + NFF);
#pragma unroll
            for (int xi = 0; xi < 4; ++xi) {
                float acc[8];
#pragma unroll
                for (int j = 0; j < 8; ++j) acc[j] = bias[j];
#pragma unroll
                for (int ky = 0; ky < 3; ++ky)
#pragma unroll
                    for (int kx = 0; kx < 3; ++kx) { const u32x4 gq = gc[ky][xi + kx]; const int k = ky * 3 + kx;
                        acc[0] += w[k][0] * bflo(gq.x); acc[1] += w[k][1] * bfhi(gq.x); acc[2] += w[k][2] * bflo(gq.y); acc[3] += w[k][3] * bfhi(gq.y);
                        acc[4] += w[k][4] * bflo(gq.z); acc[5] += w[k][5] * bfhi(gq.z); acc[6] += w[k][6] * bflo(gq.w); acc[7] += w[k][7] * bfhi(gq.w); }
                u32x4 o;
                o.x = cvt_pk_bf16(gelu_tanh(acc[0]) * bflo(vv[xi].x), gelu_tanh(acc[1]) * bfhi(vv[xi].x));
                o.y = cvt_pk_bf16(gelu_tanh(acc[2]) * bflo(vv[xi].y), gelu_tanh(acc[3]) * bfhi(vv[xi].y));
                o.z = cvt_pk_bf16(gelu_tanh(acc[4]) * bflo(vv[xi].z), gelu_tanh(acc[5]) * bfhi(vv[xi].z));
                o.w = cvt_pk_bf16(gelu_tanh(acc[6]) * bflo(vv[xi].w), gelu_tanh(acc[7]) * bfhi(vv[xi].w));
                *(u32x4*)((bf16_t*)lp[1] + (size_t)(xb + xi) * NUP + NFF) = o; } }
    }
}

__device__ __forceinline__ void final_norm_phase(const float* h, const float* g, float* out) {
    const int lane = otid() & 63, gw = blockIdx.x * 8 + (otid() >> 6), ngw = gridDim.x * 8;
    for (int row = gw; row < RL; row += ngw) {
        const float4* xr = (const float4*)(h + (size_t)row * D) + lane;
        float4 v[8]; float s = 0.f;
#pragma unroll
        for (int j = 0; j < 8; ++j) { v[j] = xr[64 * j]; s += v[j].x * v[j].x + v[j].y * v[j].y + v[j].z * v[j].z + v[j].w * v[j].w; }
        const float r = rsqrtf(wave_sum(s) * (1.f / D) + 1e-6f);
        float4* o = (float4*)(out + (size_t)row * D) + lane;
#pragma unroll
        for (int j = 0; j < 8; ++j) { const float4 gg = ((const float4*)g)[lane + 64 * j]; float4 w; w.x = v[j].x * r * gg.x; w.y = v[j].y * r * gg.y; w.z = v[j].z * r * gg.z; w.w = v[j].w * r * gg.w; o[64 * j] = w; }
    }
}

__device__ __forceinline__ void gbar(unsigned char* ws, unsigned k) {
    unsigned* base = (unsigned*)(ws + O_BAR);
    asm volatile("s_waitcnt vmcnt(0) lgkmcnt(0)" ::: "memory");
    __syncthreads();
    if (otid() == 0) {
        const unsigned g = blockIdx.x & 15u, ng = gridDim.x >> 4;
        __builtin_amdgcn_fence(__ATOMIC_RELEASE, "agent");
        const unsigned old = __hip_atomic_fetch_add(base + g * 32, 1u, __ATOMIC_RELAXED, __HIP_MEMORY_SCOPE_AGENT);
        if (old + 1u == k * ng) {
            const unsigned ot = __hip_atomic_fetch_add(base + 1024, 1u, __ATOMIC_RELAXED, __HIP_MEMORY_SCOPE_AGENT);
            if (ot + 1u == k * 16u) { for (unsigned gg = 0; gg < 16u; ++gg) __hip_atomic_store(base + 512 + gg * 32, k, __ATOMIC_RELAXED, __HIP_MEMORY_SCOPE_AGENT); }
        }
        while (__hip_atomic_load(base + 512 + g * 32, __ATOMIC_RELAXED, __HIP_MEMORY_SCOPE_AGENT) < k) __builtin_amdgcn_s_sleep(1);
        __builtin_amdgcn_fence(__ATOMIC_ACQUIRE, "agent");
    }
    __syncthreads();
}
__global__ void __launch_bounds__(512, 2) fwd_megakernel(Params p_) {
    extern __shared__ __attribute__((aligned(16))) unsigned char shm[];
    cg::grid_group grid = cg::this_grid();
    LAS unsigned char* lds = (LAS unsigned char*)shm;
#define mod ((const float*)(getp().ws + O_MOD))
#define hctx ((float*)(getp().ws + O_HCTX))
#define XN ((bf16_t*)(getp().ws + O_XN))
#define Abuf ((bf16_t*)(getp().ws + O_A))
#define GV ((bf16_t*)(getp().ws + O_GV))
    pg8::StaticOrder S;
    unsigned bar_n = 0;
#define GBAR() do { bar_n += 1u; gbar(getp().ws, bar_n); } while (0)
    { const int tid = otid();
      if (tid < 128) { const int e = tid < 64 ? tid << 6 : tid - 64; float sn, cs; sincospif((float)e * (1.f / 4096.f), &sn, &cs); ((LAS c2*)(shm + SCR_OFF + SCR_TW))[tid] = mkc2(cs, -sn); }
      __syncthreads(); }

    for (int rep = 0; rep < NREP(0); ++rep) { phase_p0(getp(), shm); grid.sync(); }
    for (int rep = 0; rep < ((REP_MASK >> 13) & 1) * 24; ++rep) GBAR();
#pragma unroll 2
    for (int layer = 0; layer < 2; ++layer) {
        const bool last = layer == 1;
#define hL (layer == 0 ? getp().in[0] : (const float*)getp().out)
#define hC (layer == 0 ? getp().in[2] : (const float*)hctx)
        const int Mrest = last ? RL : RT;
        for (int rep = 0; rep < NREP(1); ++rep) { phase_lprep(getp(), layer, shm, hL, hC); GBAR(); }
        { pg8::Gemm g{XN, (const bf16_t*)(getp().ws + O_WT_IN), RT, NIN, 2048, 2048, 2048}; S.init(g.M, g.N, gridDim.x, blockIdx.x);
          EpiStoreBf16 E{Abuf, NIN}; GEMM_REP(pg8::gemm_phase(lds, g, S, E); GBAR();) }
        for (int rep = 0; rep < NREP(3); ++rep) { phase_m1(getp(), layer, shm); GBAR(); }
        phase_m2(getp(), layer, shm, true);
        GBAR();
        for (int rep = 1; rep < NREP(4); ++rep) { phase_m2(getp(), layer, shm, false); GBAR(); }
        for (int rep = 0; rep < NREP(5); ++rep) { phase_m3(getp(), layer, shm); GBAR(); }
        { pg8::Gemm g{(const bf16_t*)(getp().ws + O_Z5), (const bf16_t*)(getp().ws + O_WT_GLU), RT, 512, 512, 512, 512}; S.init(g.M, g.N, gridDim.x, blockIdx.x);
          EpiGlu E{(const bf16_t*)(getp().ws + O_Z5), XN, getp().in[27] + layer * 512};
          GEMM_REP(pg8::gemm_phase(lds, g, S, E); GBAR();)
        }
        { pg8::Gemm g{XN, (const bf16_t*)(getp().ws + O_WT_OUT), RL, 2048, 2048, 2048, 2048}; S.init(g.M, g.N, gridDim.x, blockIdx.x);
          EpiResid E{hL, hC, getp().out, hctx, mod + (size_t)layer * 5 * 12288 + 2 * 2048}; pg8::gemm_phase(lds, g, S, E); }
        if (layer == 0) {
            for (int L2 = blockIdx.x; L2 < 256; L2 += gridDim.x) { const int part = L2 & 7, uu = L2 >> 3; pg8::SingleOrder S1{RL / 256 + (uu & 3), uu >> 2, true};
            pg8::Gemm g{XN + part * 256, (const bf16_t*)(getp().ws + O_WT_OUT) + part * 256, RT, 2048, 256, 2048, 2048};
            EpiResidAtomic E{hctx, mod + (size_t)(layer * 5 + 4) * 12288 + 2 * 2048}; pg8::gemm_phase(lds, g, S1, E); }
        }
        GBAR();
        { const int tid = otid(); for (int row = blockIdx.x * 8 + (tid >> 6); row < Mrest; row += gridDim.x * 8) xn_row1(getp(), layer, 1, row, tid & 63, getp().out, hctx); }
        GBAR();
        for (int rep = 1; rep < NREP(6); ++rep) { const int tid = otid(); for (int row = blockIdx.x * 8 + (tid >> 6); row < Mrest; row += gridDim.x * 8) xn_row1(getp(), layer, 1, row, tid & 63, getp().out, hctx); GBAR(); }
        { pg8::Gemm g{XN, (const bf16_t*)(getp().ws + O_WT_UP), Mrest, NUP, 2048, 2048, 2048}; S.init(g.M, g.N, gridDim.x, blockIdx.x);
          EpiStoreBf16 E{GV, NUP};
          pg8::gemm_phase(lds, g, S, E);
          GBAR(); }
        phase_conv(getp(), layer, last ? 256 : 272);
        GBAR();
        { pg8::Gemm g{GV + NFF, (const bf16_t*)(getp().ws + O_WT_DOWN), RL, 2048, NFF, NUP, NFF}; S.init(g.M, g.N, gridDim.x, blockIdx.x);
          EpiResid E{getp().out, hctx, getp().out, hctx, mod + (size_t)layer * 5 * 12288 + 5 * 2048}; pg8::gemm_phase(lds, g, S, E); }
        if (layer == 0) {
            for (int L2 = blockIdx.x; L2 < 128; L2 += gridDim.x) { const int part = L2 & 3, uu = L2 >> 2; pg8::SingleOrder S1{RL / 256 + (uu & 3), (uu >> 2) & 7, true};
            pg8::Gemm g{GV + NFF + part * 1408, (const bf16_t*)(getp().ws + O_WT_DOWN) + part * 1408, RT, 2048, 1408, NUP, NFF};
            EpiResidAtomic E{hctx, mod + (size_t)(layer * 5 + 4) * 12288 + 5 * 2048}; pg8::gemm_phase(lds, g, S1, E); }
        }
        GBAR();
    }
    final_norm_phase(getp().out, getp().in[34], getp().out);
}

extern "C" void kernel_launch(void* const* d_in, const int* in_sizes, int n_in, void* d_out, int out_size, void* d_ws, size_t ws_size, hipStream_t stream) {
    static int grid_blocks = 0;
    if (grid_blocks == 0) {
        int dev = 0, cus = 0, per_cu = 0;
        (void)hipGetDevice(&dev);
        (void)hipDeviceGetAttribute(&cus, hipDeviceAttributeMultiprocessorCount, dev);
        if (hipFuncSetAttribute((const void*)fwd_megakernel, hipFuncAttributeMaxDynamicSharedMemorySize, LDS_BYTES) != hipSuccess) fprintf(stderr, "hipFuncSetAttribute failed\n");
        (void)hipOccupancyMaxActiveBlocksPerMultiprocessor(&per_cu, (const void*)fwd_megakernel, 512, LDS_BYTES);
        (void)hipGetLastError();
        grid_blocks = cus & ~15;
        if (n_in != 35 || ws_size < O_END2) { fprintf(stderr, "kernel_launch: unexpected n_in %d or workspace %zu < %zu\n", n_in, ws_size, (size_t)O_END2); grid_blocks = -1; }
    }
    if (grid_blocks < 0) return;
    Params p{};
    for (int i = 0; i < 35; ++i) p.in[i] = (const float*)d_in[i];
    p.out = (float*)d_out; p.ws = (unsigned char*)d_ws; p.ws_size = (unsigned long long)ws_size;
    void* args[] = {&p};
    hipError_t e = hipLaunchCooperativeKernel((const void*)fwd_megakernel, dim3(grid_blocks), dim3(512), args, LDS_BYTES, stream);
    if (e != hipSuccess) fprintf(stderr, "cooperative launch failed: %s (grid %d)\n", hipGetErrorString(e), grid_blocks);
}
```
